# Optimizing an MI355X kernel written in HIP

```python
import math, functools
import jax, jax.numpy as jnp
from jax import lax
import numpy as np


D_MODEL = 1024
BATCH = 32
SEQ = 2048
DEPTH = 1
DEC_BATCH = 8
DEC_SEQ = 16
PAST_LEN = 1024

CHUNK = 64
Q_BLOCK = 128
MLSTM_WIDTH = D_MODEL // 2
DIFF_WIDTH = D_MODEL - MLSTM_WIDTH
MLSTM_V_DIM = 128
MLSTM_QK_DIM = MLSTM_V_DIM // 2
N_MLSTM_HEADS = MLSTM_WIDTH // MLSTM_V_DIM
DIFF_V_DIM = 128
DIFF_QK_DIM = DIFF_V_DIM // 2
N_DIFF_HEADS = DIFF_WIDTH // DIFF_V_DIM
ROPE_DIM = DIFF_QK_DIM // 4
ROPE_THETA = 500000.0
D_FF = 2816
N_ADA = 9
NORM_EPS = 1e-6
PROJ_SIZES = (N_MLSTM_HEADS * MLSTM_QK_DIM, N_MLSTM_HEADS * MLSTM_QK_DIM, N_MLSTM_HEADS * MLSTM_V_DIM,
              MLSTM_WIDTH, N_MLSTM_HEADS, N_MLSTM_HEADS,
              N_DIFF_HEADS * 2 * DIFF_QK_DIM, N_DIFF_HEADS * 2 * DIFF_QK_DIM, N_DIFF_HEADS * DIFF_V_DIM)
PROJ_WIDTH = (3 * N_MLSTM_HEADS * MLSTM_QK_DIM + N_MLSTM_HEADS * MLSTM_V_DIM + MLSTM_WIDTH + 2 * N_MLSTM_HEADS
              + 4 * N_DIFF_HEADS * DIFF_QK_DIM + N_DIFF_HEADS * DIFF_V_DIM) - N_MLSTM_HEADS * MLSTM_QK_DIM

kernel_name = 'hybrid_mlstm_diffattn_streaming_step'


def rms_norm(x, g):
    xf = x.astype(jnp.float32)
    y = xf * lax.rsqrt(jnp.mean(xf * xf, axis=-1, keepdims=True) + NORM_EPS)
    return (y * g.astype(jnp.float32)).astype(x.dtype)


def modulate(x, g, shift, scale):
    return rms_norm(x, g) * (1 + scale[:, None, :]) + shift[:, None, :]


def residual(x, out, g, gate, weight):
    return x + weight * gate[:, None, :] * rms_norm(out, g)


def swiglu(h, w_in, w_out):
    gate, up = jnp.split(h @ w_in, 2, axis=-1)
    return (jax.nn.silu(gate) * up) @ w_out


def ada_params(c, w_ada, b_ada):
    mod = jax.nn.silu(c) @ w_ada + b_ada
    return mod.reshape(c.shape[0], N_ADA, D_MODEL)


def partial_rope(x, pos):
    half = ROPE_DIM // 2
    inv_freq = ROPE_THETA ** (-jnp.arange(half, dtype=jnp.float32) * (2.0 / ROPE_DIM))
    ang = pos.astype(jnp.float32)[:, None] * inv_freq[None, :]
    cos = jnp.cos(ang)[None, :, None, None, :]
    sin = jnp.sin(ang)[None, :, None, None, :]
    xr = x[..., :ROPE_DIM].astype(jnp.float32)
    x1, x2 = xr[..., :half], xr[..., half:]
    rot = jnp.concatenate([x1 * cos - x2 * sin, x2 * cos + x1 * sin], axis=-1).astype(x.dtype)
    return jnp.concatenate([rot, x[..., ROPE_DIM:]], axis=-1)


def project(h, w_in, b_igate, b_fgate, pos):
    B, T, _ = h.shape
    f32 = jnp.float32
    idx = [int(i) for i in np.cumsum(PROJ_SIZES)[:-1]]
    mq, mk, mv, mo, mi, mf, dq, dk, dv = jnp.split(h @ w_in, idx, axis=-1)
    mq = mq.reshape(B, T, N_MLSTM_HEADS, MLSTM_QK_DIM).astype(f32)
    mk = mk.reshape(B, T, N_MLSTM_HEADS, MLSTM_QK_DIM).astype(f32) * (MLSTM_QK_DIM ** -0.5)
    mv = mv.reshape(B, T, N_MLSTM_HEADS, MLSTM_V_DIM).astype(f32)
    o_gate = jax.nn.sigmoid(mo)
    i_pre = (mi + b_igate).astype(f32)
    log_f = jax.nn.log_sigmoid((mf + b_fgate).astype(f32))
    dq = partial_rope(dq.reshape(B, T, N_DIFF_HEADS, 2, DIFF_QK_DIM), pos)
    dk = partial_rope(dk.reshape(B, T, N_DIFF_HEADS, 2, DIFF_QK_DIM), pos)
    dv = dv.reshape(B, T, N_DIFF_HEADS, DIFF_V_DIM)
    return (mq, mk, mv, i_pre, log_f), o_gate, (dq, dk, dv)


def mlstm_chunk(carry, inp):
    C, n, m = carry
    q, k, v, i_pre, log_f = inp
    L = q.shape[1]
    b = jnp.moveaxis(jnp.cumsum(log_f, axis=1), 1, 2)
    ig = jnp.moveaxis(i_pre, 1, 2)
    dmat = b[..., :, None] - b[..., None, :] + ig[..., None, :]
    causal = jnp.tril(jnp.ones((L, L), dtype=bool))
    dmat = jnp.where(causal, dmat, -jnp.inf)
    inter = b + m[..., None]
    m_t = jnp.maximum(inter, jnp.max(dmat, axis=-1))
    w_intra = jnp.exp(dmat - m_t[..., None])
    w_inter = jnp.exp(inter - m_t)
    s = jnp.einsum('blhd,bshd->bhls', q, k) * w_intra
    num = (jnp.einsum('bhls,bshv->blhv', s, v)
           + jnp.einsum('bhvd,blhd->blhv', C, q) * jnp.moveaxis(w_inter, 1, 2)[..., None])
    den = jnp.sum(s, axis=-1) + w_inter * jnp.einsum('bhd,blhd->bhl', n, q)
    den = jnp.maximum(jnp.abs(den), jnp.exp(-m_t))
    h = num / jnp.moveaxis(den, 1, 2)[..., None]
    m_last = m_t[..., -1]
    w_state = jnp.exp(b[..., -1] + m - m_last)
    w_rows = jnp.exp(b[..., -1:] - b + ig - m_last[..., None])
    C_new = w_state[..., None, None] * C + jnp.einsum('bhs,bshv,bshd->bhvd', w_rows, v, k)
    n_new = w_state[..., None] * n + jnp.einsum('bhs,bshd->bhd', w_rows, k)
    return (C_new, n_new, m_last), h


def mlstm_readout(h, o_gate, g):
    B, T = h.shape[:2]
    return rms_norm(h, g).reshape(B, T, MLSTM_WIDTH).astype(o_gate.dtype) * o_gate


def diff_lambda(lam_qk, layer):
    lam_init = 0.8 - 0.6 * math.exp(-0.3 * layer)
    lf = lam_qk.astype(jnp.float32)
    lam = jnp.exp(jnp.sum(lf[0] * lf[1])) - jnp.exp(jnp.sum(lf[2] * lf[3])) + lam_init
    return lam, lam_init


def diff_weights(scores, lam):
    p = jax.nn.softmax(scores, axis=-1)
    return p[:, :, 0] - lam * p[:, :, 1]


def diff_attn_prompt(q, k, v, lam):
    B, S = q.shape[:2]
    nb = S // Q_BLOCK
    q_blocks = jnp.moveaxis(q.reshape(B, nb, Q_BLOCK, N_DIFF_HEADS, 2, DIFF_QK_DIM), 1, 0)
    key_chunk = jnp.arange(S) // CHUNK
    vf = v.astype(jnp.float32)
    scale = DIFF_QK_DIM ** -0.5

    def one_block(args):
        qb, blk = args
        q_chunk = (blk * Q_BLOCK + jnp.arange(Q_BLOCK)) // CHUNK
        s = jnp.einsum('bqhcd,bkhcd->bhcqk', qb, k).astype(jnp.float32) * scale
        visible = key_chunk[None, :] <= q_chunk[:, None]
        s = jnp.where(visible, s, -jnp.inf)
        return jnp.einsum('bhqk,bkhd->bqhd', diff_weights(s, lam), vf)

    out = lax.map(one_block, (q_blocks, jnp.arange(nb)))
    return jnp.moveaxis(out, 0, 1).reshape(B, S, N_DIFF_HEADS, DIFF_V_DIM)


def diff_readout(o, g, lam_init):
    B, T = o.shape[:2]
    return (rms_norm(o, g) * (1 - lam_init)).reshape(B, T, DIFF_WIDTH)


def mixer_prompt(h, w_in, b_igate, b_fgate, g_mlstm, g_diff, lam, lam_init):
    B, S, _ = h.shape
    pos = jnp.arange(S)
    m_inputs, o_gate, (dq, dk, dv) = project(h, w_in, b_igate, b_fgate, pos)
    n_chunks = S // CHUNK
    chunked = tuple(jnp.moveaxis(a.reshape(B, n_chunks, CHUNK, *a.shape[2:]), 1, 0) for a in m_inputs)
    f32 = jnp.float32
    carry0 = (jnp.zeros((B, N_MLSTM_HEADS, MLSTM_V_DIM, MLSTM_QK_DIM), f32),
              jnp.zeros((B, N_MLSTM_HEADS, MLSTM_QK_DIM), f32),
              jnp.zeros((B, N_MLSTM_HEADS), f32))
    (C, n, m), hm = lax.scan(mlstm_chunk, carry0, chunked)
    hm = jnp.moveaxis(hm, 0, 1).reshape(B, S, N_MLSTM_HEADS, MLSTM_V_DIM)
    y_m = mlstm_readout(hm, o_gate, g_mlstm)
    y_d = diff_readout(diff_attn_prompt(dq, dk, dv, lam), g_diff, lam_init)
    heads = jnp.concatenate([y_m.astype(h.dtype), y_d.astype(h.dtype)], axis=-1)
    new_state = (dk.reshape(B, S, N_DIFF_HEADS, 2 * DIFF_QK_DIM), dv,
                 C.astype(h.dtype), n.astype(h.dtype), m.astype(h.dtype))
    return heads, new_state


def mixer_sample(h, cache_k, cache_v, state_C, state_n, state_m, w_in, b_igate, b_fgate,
                 g_mlstm, g_diff, lam, lam_init):
    B, T, _ = h.shape
    P = cache_k.shape[1]
    pos = P + jnp.arange(T)
    m_inputs, o_gate, (dq, dk, dv) = project(h, w_in, b_igate, b_fgate, pos)
    f32 = jnp.float32
    carry = (state_C.astype(f32), state_n.astype(f32), state_m.astype(f32))
    (C, n, m), hm = mlstm_chunk(carry, m_inputs)
    y_m = mlstm_readout(hm, o_gate, g_mlstm)
    k_all = jnp.concatenate([cache_k.reshape(B, P, N_DIFF_HEADS, 2, DIFF_QK_DIM), dk], axis=1)
    v_all = jnp.concatenate([cache_v, dv], axis=1)
    s = jnp.einsum('bqhcd,bkhcd->bhcqk', dq, k_all).astype(f32) * (DIFF_QK_DIM ** -0.5)
    o = jnp.einsum('bhqk,bkhd->bqhd', diff_weights(s, lam), v_all.astype(f32))
    y_d = diff_readout(o, g_diff, lam_init)
    heads = jnp.concatenate([y_m.astype(h.dtype), y_d.astype(h.dtype)], axis=-1)
    new_state = (dk.reshape(B, T, N_DIFF_HEADS, 2 * DIFF_QK_DIM), dv,
                 C.astype(h.dtype), n.astype(h.dtype), m.astype(h.dtype))
    return heads, new_state


def trunk_layer(x, c, mixer, w_ada, b_ada, g_norm, w_ffn1_in, w_ffn1_out, w_out, w_ffn2_in, w_ffn2_out):
    mod = ada_params(c, w_ada, b_ada)
    x = residual(x, swiglu(modulate(x, g_norm[0], mod[:, 0], mod[:, 1]), w_ffn1_in, w_ffn1_out),
                 g_norm[1], mod[:, 2], 0.5)
    heads, new_state = mixer(modulate(x, g_norm[2], mod[:, 3], mod[:, 4]))
    x = residual(x, heads @ w_out, g_norm[3], mod[:, 5], 1.0)
    x = residual(x, swiglu(modulate(x, g_norm[4], mod[:, 6], mod[:, 7]), w_ffn2_in, w_ffn2_out),
                 g_norm[5], mod[:, 8], 0.5)
    return x, new_state


def setup_inputs(seed: int = 0) -> dict:
    key = jax.random.key(seed)
    ks = jax.random.split(key, 24)
    f32 = jnp.float32

    def nrm(k, shape, s):
        return jax.random.normal(k, shape, f32) * s

    return {
        'x_prompt': nrm(ks[0], (BATCH, SEQ, D_MODEL), 1.0),
        'x_sample': nrm(ks[1], (DEC_BATCH, DEC_SEQ, D_MODEL), 1.0),
        'cache_k': nrm(ks[2], (DEPTH, DEC_BATCH, PAST_LEN, N_DIFF_HEADS, 2 * DIFF_QK_DIM), 1.0),
        'cache_v': nrm(ks[3], (DEPTH, DEC_BATCH, PAST_LEN, N_DIFF_HEADS, DIFF_V_DIM), 1.0),
        'state_C': nrm(ks[4], (DEPTH, DEC_BATCH, N_MLSTM_HEADS, MLSTM_V_DIM, MLSTM_QK_DIM), 0.3),
        'state_n': nrm(ks[5], (DEPTH, DEC_BATCH, N_MLSTM_HEADS, MLSTM_QK_DIM), 1.0),
        'state_m': nrm(ks[6], (DEPTH, DEC_BATCH, N_MLSTM_HEADS), 0.5),
        'c_prompt': nrm(ks[7], (BATCH, D_MODEL), 1.0),
        'c_sample': nrm(ks[8], (DEC_BATCH, D_MODEL), 1.0),
        'w_ada': nrm(ks[9], (DEPTH, D_MODEL, N_ADA * D_MODEL), D_MODEL ** -0.5),
        'b_ada': nrm(ks[10], (DEPTH, N_ADA * D_MODEL), 0.01),
        'g_norm': 1.0 + nrm(ks[11], (DEPTH, 6, D_MODEL), 0.05),
        'w_ffn1_in': nrm(ks[12], (DEPTH, D_MODEL, 2 * D_FF), D_MODEL ** -0.5),
        'w_ffn1_out': nrm(ks[13], (DEPTH, D_FF, D_MODEL), D_FF ** -0.5),
        'w_in': nrm(ks[14], (DEPTH, D_MODEL, PROJ_WIDTH), D_MODEL ** -0.5),
        'b_igate': nrm(ks[15], (DEPTH, N_MLSTM_HEADS), 0.1),
        'b_fgate': jnp.linspace(3.0, 6.0, N_MLSTM_HEADS, dtype=f32)[None, :] + nrm(ks[16], (DEPTH, N_MLSTM_HEADS), 0.1),
        'g_mlstm': 1.0 + nrm(ks[17], (DEPTH, N_MLSTM_HEADS, MLSTM_V_DIM), 0.05),
        'g_diff': 1.0 + nrm(ks[18], (DEPTH, N_DIFF_HEADS, DIFF_V_DIM), 0.05),
        'lambda_qk': nrm(ks[19], (DEPTH, 4, DIFF_QK_DIM), 0.1),
        'w_out': nrm(ks[20], (DEPTH, D_MODEL, D_MODEL), D_MODEL ** -0.5),
        'w_ffn2_in': nrm(ks[21], (DEPTH, D_MODEL, 2 * D_FF), D_MODEL ** -0.5),
        'w_ffn2_out': nrm(ks[22], (DEPTH, D_FF, D_MODEL), D_FF ** -0.5),
    }


def reference(x_prompt, x_sample, cache_k, cache_v, state_C, state_n, state_m, c_prompt, c_sample,
              w_ada, b_ada, g_norm, w_ffn1_in, w_ffn1_out, w_in, b_igate, b_fgate, g_mlstm, g_diff,
              lambda_qk, w_out, w_ffn2_in, w_ffn2_out):
    y_p, y_s = x_prompt, x_sample
    states_p, states_s = [], []
    for l in range(DEPTH):
        lam, lam_init = diff_lambda(lambda_qk[l], l)
        mix_p = functools.partial(mixer_prompt, w_in=w_in[l], b_igate=b_igate[l], b_fgate=b_fgate[l],
                                  g_mlstm=g_mlstm[l], g_diff=g_diff[l], lam=lam, lam_init=lam_init)
        mix_s = functools.partial(mixer_sample, cache_k=cache_k[l], cache_v=cache_v[l], state_C=state_C[l],
                                  state_n=state_n[l], state_m=state_m[l], w_in=w_in[l], b_igate=b_igate[l],
                                  b_fgate=b_fgate[l], g_mlstm=g_mlstm[l], g_diff=g_diff[l],
                                  lam=lam, lam_init=lam_init)
        y_p, st_p = trunk_layer(y_p, c_prompt, mix_p, w_ada[l], b_ada[l], g_norm[l], w_ffn1_in[l],
                                w_ffn1_out[l], w_out[l], w_ffn2_in[l], w_ffn2_out[l])
        y_s, st_s = trunk_layer(y_s, c_sample, mix_s, w_ada[l], b_ada[l], g_norm[l], w_ffn1_in[l],
                                w_ffn1_out[l], w_out[l], w_ffn2_in[l], w_ffn2_out[l])
        states_p.append(st_p)
        states_s.append(st_s)
    k_p, v_p, C_p, n_p, m_p = [jnp.stack(a, axis=0) for a in zip(*states_p)]
    k_s, v_s, C_s, n_s, m_s = [jnp.stack(a, axis=0) for a in zip(*states_s)]
    return (y_p, y_s, k_p, v_p, C_p, n_p, m_p, k_s, v_s, C_s, n_s, m_s)
```

```cpp
#include <hip/hip_runtime.h>
#include <hip/hip_cooperative_groups.h>
#include <cstdio>
#include <cstdint>
#include <cmath>
namespace pg8 {
#define PG8_LAS __attribute__((address_space(3)))
typedef unsigned short bf16_t;
typedef short bf16x8 __attribute__((ext_vector_type(8)));
typedef float f32x4 __attribute__((ext_vector_type(4)));
typedef unsigned u32x4 __attribute__((ext_vector_type(4)));
typedef int v8i32 __attribute__((ext_vector_type(8)));
typedef int v4i32 __attribute__((ext_vector_type(4)));
constexpr int BM = 256, BK = 64, HALF = 128, HTB = HALF * BK * 2  , STAGE_BYTES = 8 * HTB, NXCD = 8, WGM = 8;

__host__ __device__ __forceinline__ int lds_byte(int r, int c) { const int st = (r >> 4) * 2 + (c >> 5), rr = r & 15, cc = c & 31, ob = rr * 64 + cc * 2; return st * 1024 + (ob ^ (((ob >> 9) & 1) << 5)); }
__host__ __device__ __forceinline__ void stage_rc(int b, int& R, int& C) { const int st = b / 1024, sb = b % 1024, swz = sb ^ (((sb >> 9) & 1) << 5); R = (st >> 1) * 16 + swz / 64; C = (st & 1) * 32 + (swz % 64) / 2; }
__host__ __device__ __forceinline__ int perm32(int rho) { const int n = rho >> 4, i = rho & 15; return 8 * (i >> 2) + 4 * n + (i & 3); }

struct Unit { int pm, pn; };
struct Gemm { const bf16_t* A; const bf16_t* Bt; int M, N, K; };

struct StaticOrder {
    int nM, nN, nwg, G, c;
    __host__ __device__ void init(int M, int N, int G_, int c_) { nM = M / BM; nN = N / BM; nwg = nM * nN; G = G_; c = c_; }
    __host__ __device__ bool next(int i, Unit& u) const {
        const long L = (long)i * G + c; if (L >= nwg) return false;
        int wgid = (int)L; { const int q = nwg / NXCD, r = nwg % NXCD, xcd = wgid % NXCD, off = wgid / NXCD; wgid = (xcd < r ? xcd * (q + 1) : r * (q + 1) + (xcd - r) * q) + off; }
        const int nig = WGM * nN, gid = wgid / nig, fm = gid * WGM, gsz = (nM - fm) < WGM ? (nM - fm) : WGM;
        u.pm = fm + ((wgid % nig) % gsz); u.pn = (wgid % nig) / gsz; return true;
    }
    __device__ __forceinline__ void a_ready(const Unit&) const {}
    __device__ __forceinline__ void done(const Unit&) const {}
};
__device__ __forceinline__ unsigned cvt_pk_bf16(float lo, float hi) { unsigned r; asm volatile("v_cvt_pk_bf16_f32 %0, %1, %2" : "=v"(r) : "v"(lo), "v"(hi)); return r; }
typedef float f32x2 __attribute__((ext_vector_type(2)));
typedef unsigned u32x4 __attribute__((ext_vector_type(4)));
constexpr int E_MP = 65536, E_MV = 65664;
__device__ __forceinline__ float fast_sigmoid(float x) { return __builtin_amdgcn_rcpf(1.0f + __expf(-x)); }
struct EpiSwiglu {
    static constexpr bool PERM = true, AFTER_DRAIN = false;
    bf16_t* O; int ldo; float sc;
    __device__ __forceinline__ void operator()(const f32x4 (&acc)[2][2][4][2], const Unit& u, int wr, int wc, int fr, int fq) const {
        const int row0 = u.pm * BM + wr * 64 + fr, col0 = u.pn * 128 + wc * 32 + 8 * fq;
#pragma unroll
        for (int ai = 0; ai < 2; ++ai)
#pragma unroll
            for (int m = 0; m < 4; ++m) {
                bf16_t* p = O + (size_t)(row0 + ai * HALF + m * 16) * ldo + col0;
                const f32x4 g0 = acc[ai][0][m][0] * sc, g1 = acc[ai][0][m][1] * sc, u0 = acc[ai][1][m][0] * sc, u1 = acc[ai][1][m][1] * sc;
                f32x4 a0, a1;
#pragma unroll
                for (int j = 0; j < 4; ++j) { a0[j] = g0[j] * fast_sigmoid(g0[j]) * u0[j]; a1[j] = g1[j] * fast_sigmoid(g1[j]) * u1[j]; }
                u32x4 w; w.x = cvt_pk_bf16(a0[0], a0[1]); w.y = cvt_pk_bf16(a0[2], a0[3]); w.z = cvt_pk_bf16(a1[0], a1[1]); w.w = cvt_pk_bf16(a1[2], a1[3]);
                *(u32x4*)p = w;
            }
    }
};
struct EpiSwiglu8 {
    static constexpr bool PERM = false, AFTER_DRAIN = false;
    bf16_t* O; int ldo; float sc;
    __device__ __forceinline__ void operator()(const f32x4 (&acc)[2][2][4][2], const Unit& u, int wr, int wc, int fr, int fq) const {
        typedef unsigned u32x2e __attribute__((ext_vector_type(2)));
        const int row0 = u.pm * BM + wr * 64 + fr, col0 = u.pn * 128 + wc * 32 + 4 * fq;
#pragma unroll
        for (int ai = 0; ai < 2; ++ai)
#pragma unroll
            for (int m = 0; m < 4; ++m) {
                bf16_t* p = O + (size_t)(row0 + ai * HALF + m * 16) * ldo + col0;
#pragma unroll
                for (int n = 0; n < 2; ++n) {
                    const f32x4 g = acc[ai][0][m][n] * sc, up = acc[ai][1][m][n] * sc;
                    f32x4 a0;
#pragma unroll
                    for (int j = 0; j < 4; ++j) a0[j] = g[j] * fast_sigmoid(g[j]) * up[j];
                    u32x2e w; w.x = cvt_pk_bf16(a0[0], a0[1]); w.y = cvt_pk_bf16(a0[2], a0[3]);
                    *(u32x2e*)(p + 16 * n) = w;
                }
            }
    }
};
struct EpiSwigluF8 {
    static constexpr bool PERM = false, AFTER_DRAIN = false;
    unsigned char* O; int ldo; float sc, so;
    __device__ __forceinline__ void operator()(const f32x4 (&acc)[2][2][4][2], const Unit& u, int wr, int wc, int fr, int fq) const {
        const int row0 = u.pm * BM + wr * 64 + fr, col0 = u.pn * 128 + wc * 32 + 4 * fq;
#pragma unroll
        for (int ai = 0; ai < 2; ++ai)
#pragma unroll
            for (int m = 0; m < 4; ++m) {
                unsigned char* p = O + (size_t)(row0 + ai * HALF + m * 16) * ldo + col0;
#pragma unroll
                for (int n = 0; n < 2; ++n) {
                    const f32x4 g = acc[ai][0][m][n] * sc, up = acc[ai][1][m][n] * sc;
                    f32x4 a0;
#pragma unroll
                    for (int j = 0; j < 4; ++j) a0[j] = g[j] * fast_sigmoid(g[j]) * up[j] * so;
                    unsigned q = 0u;
                    q = __builtin_amdgcn_cvt_pk_fp8_f32(a0[0], a0[1], q, false); q = __builtin_amdgcn_cvt_pk_fp8_f32(a0[2], a0[3], q, true);
                    *(unsigned*)(p + 16 * n) = q;
                }
            }
    }
};
struct EpiPlain {
    static constexpr bool PERM = true, AFTER_DRAIN = false;
    bf16_t* O; int ldo; float sc;
    __device__ __forceinline__ void operator()(const f32x4 (&acc)[2][2][4][2], const Unit& u, int wr, int wc, int fr, int fq) const {
        const int row0 = u.pm * BM + wr * 64 + fr, col0 = u.pn * BM + wc * 32 + 8 * fq;
#pragma unroll
        for (int ai = 0; ai < 2; ++ai)
#pragma unroll
            for (int m = 0; m < 4; ++m) {
                bf16_t* p = O + (size_t)(row0 + ai * HALF + m * 16) * ldo + col0;
#pragma unroll
                for (int bj = 0; bj < 2; ++bj) {
                    const f32x4 v0 = acc[ai][bj][m][0] * sc, v1 = acc[ai][bj][m][1] * sc;
                    u32x4 w; w.x = cvt_pk_bf16(v0[0], v0[1]); w.y = cvt_pk_bf16(v0[2], v0[3]); w.z = cvt_pk_bf16(v1[0], v1[1]); w.w = cvt_pk_bf16(v1[2], v1[3]);
                    *(u32x4*)(p + bj * HALF) = w;
                }
            }
    }
};
struct EpiProj {
    static constexpr bool PERM = true, AFTER_DRAIN = false;
    bf16_t* P; bf16_t* SK; bf16_t* SV; float* okp; float* ovp; float* oks; float* ovs; const float* rope;
    __device__ __forceinline__ void operator()(const f32x4 (&acc)[2][2][4][2], const Unit& u, int wr, int wc, int fr, int fq) const {
        const int pn = u.pn;
        const int type = (pn == 0) ? 0 : (pn == 1) ? 1 : (pn < 4) ? 2 : (pn < 6) ? 3 : (pn < 8) ? 4 : (pn < 10) ? 5 : 6;
        const bool rot = (type == 4 || type == 5) && ((wc & 1) == 0);
#pragma unroll
        for (int ai = 0; ai < 2; ++ai)
#pragma unroll
            for (int m = 0; m < 4; ++m) {
                const int row = u.pm * BM + ai * HALF + wr * 64 + m * 16 + fr;
                const bool samp = row >= E_MP, valid = row < E_MV;
                const int pos = samp ? 1024 + ((row - E_MP) & 15) : (row & 2047);
                f32x4 cs0 = {1.f, 1.f, 1.f, 1.f}, cs1 = cs0, sn0 = {0.f, 0.f, 0.f, 0.f}, sn1 = sn0;
                if (rot) { const float* t = rope + pos * 16; cs0 = *(const f32x4*)t; cs1 = *(const f32x4*)(t + 4); sn0 = *(const f32x4*)(t + 8); sn1 = *(const f32x4*)(t + 12); }
#pragma unroll
                for (int bj = 0; bj < 2; ++bj) {
                    f32x4 v0 = acc[ai][bj][m][0], v1 = acc[ai][bj][m][1];
                    if (type == 1) { v0 = v0 * 0.125f; v1 = v1 * 0.125f; }
                    else if (type == 3) {
#pragma unroll
                        for (int j = 0; j < 4; ++j) { v0[j] = fast_sigmoid(v0[j]); v1[j] = fast_sigmoid(v1[j]); }
                    } else if (rot) {
                        f32x4 p0, p1;
#pragma unroll
                        for (int j = 0; j < 4; ++j) { p0[j] = __shfl_xor(v0[j], 16); p1[j] = __shfl_xor(v1[j], 16); }
                        if (fq == 0) { v0 = v0 * cs0 - p0 * sn0; v1 = v1 * cs1 - p1 * sn1; }
                        else if (fq == 1) { v0 = v0 * cs0 + p0 * sn0; v1 = v1 * cs1 + p1 * sn1; }
                    }
                    const int c512 = (pn & 1) * 256 + bj * HALF + wc * 32 + 8 * fq;
                    if (type >= 5 && valid) {
                        float* o = samp ? ((type == 5 ? oks : ovs) + (size_t)(row - E_MP) * 512 + c512) : ((type == 5 ? okp : ovp) + (size_t)row * 512 + c512);
                        *(f32x4*)o = v0; *(f32x4*)(o + 4) = v1;
                    }
                    if (type == 4) { v0 = v0 * (0.125f * 1.4426950408889634f); v1 = v1 * (0.125f * 1.4426950408889634f); }
                    u32x4 w; w.x = cvt_pk_bf16(v0[0], v0[1]); w.y = cvt_pk_bf16(v0[2], v0[3]); w.z = cvt_pk_bf16(v1[0], v1[1]); w.w = cvt_pk_bf16(v1[2], v1[3]);
                    *(u32x4*)(P + (size_t)row * 3072 + pn * BM + bj * HALF + wc * 32 + 8 * fq) = w;
                    if (type >= 5 && samp && valid) {
                        const int s = row - E_MP;
                        bf16_t* d = (type == 5 ? SK : SV) + ((size_t)((s >> 4) * 1088 + 1024 + (s & 15)) * 512 + c512);
                        *(u32x4*)d = w;
                    }
                }
            }
    }
};
template <class Epi, class Sched, bool ALIGN_EPI = false, bool SP2 = false, bool F8 = false  >
__device__ __forceinline__ void gemm_phase(PG8_LAS unsigned char* lds, const Gemm g, const Sched& S, const Epi& E) {
    int tid = threadIdx.x; asm volatile("" : "+v"(tid));
    const int wid = __builtin_amdgcn_readfirstlane(tid >> 6), lane = tid & 63, wr = wid >> 2, wc = wid & 3, fr = lane & 15, fq = lane >> 4;
    const int K = g.K, nt = K / BK;
    unsigned voffA[2], voffB[2];
    { int R, C; stage_rc(tid * 16, R, C); const int Rb = Epi::PERM ? ((R & ~31) + perm32(R & 31)) : R;
        voffA[0] = (unsigned)(R * K + C) * 2u; voffB[0] = (unsigned)(Rb * K + C) * 2u; voffA[1] = voffA[0] + (unsigned)(64 * K) * 2u; voffB[1] = voffB[0] + (unsigned)(64 * K) * 2u; }
    const size_t kstep = (size_t)(BK * 2);
    const size_t hstep = (size_t)HALF * K * 2;
    const size_t tstep = 2 * hstep;
    const unsigned ldsbase = (unsigned)(uintptr_t)lds; const size_t r64step = (size_t)(64 * K) * 2u;
    const unsigned ldsw = (unsigned)wid * 1024u;
    const int aoff = lds_byte(wr * 64 + fr, fq * 8), boff = lds_byte(wc * 32 + fr, fq * 8);
#define PG8_SA(b, h) (((b) * 2 + (h)) * HTB)
#define PG8_SB(b, h) ((4 + (b) * 2 + (h)) * HTB)
#define PG8_GLDS(vo, gp, ld) do { unsigned _keep; asm volatile("s_mov_b32 %0, m0\n\ts_mov_b32 m0, %3\n\ts_nop 0\n\tglobal_load_lds_dwordx4 %1, %2\n\ts_mov_b32 m0, %0" : "=&s"(_keep) : "v"(vo), "s"(gp), "s"(ld) : "memory"); } while (0)
#define PG8_STAGE(bufoff, gbase, voff) do { const char* _g = (const char*)(gbase); const unsigned _l = ldsbase + (unsigned)(bufoff) + ldsw; \
        PG8_GLDS((voff)[0], _g, _l); PG8_GLDS((voff)[0], _g + r64step, _l + 8192u); } while (0)
#define PG8_LDA(dst, b, h) do { _Pragma("unroll") for (int m = 0; m < 4; ++m) _Pragma("unroll") for (int k = 0; k < 2; ++k) dst[m][k] = *(const PG8_LAS v4i32*)(lds + PG8_SA(b, h) + aoff + m * 2048 + k * 1024); } while (0)
#define PG8_LDB(dst, b, h) do { _Pragma("unroll") for (int n = 0; n < 2; ++n) _Pragma("unroll") for (int k = 0; k < 2; ++k) dst[n][k] = *(const PG8_LAS v4i32*)(lds + PG8_SB(b, h) + boff + n * 2048 + k * 1024); } while (0)
#define PG8_CAT(x0, x1) __builtin_shufflevector(x0, x1, 0, 1, 2, 3, 4, 5, 6, 7)
#define PG8_MMA(ai, bj, At, Bt) do { __builtin_amdgcn_s_setprio(1); _Pragma("unroll") for (int m = 0; m < 4; ++m) _Pragma("unroll") for (int n = 0; n < 2; ++n) { \
        if constexpr (F8) { acc[ai][bj][m][n] = __builtin_amdgcn_mfma_scale_f32_16x16x128_f8f6f4(PG8_CAT(Bt[n][0], Bt[n][1]), PG8_CAT(At[m][0], At[m][1]), acc[ai][bj][m][n], 0, 0, 0, 0x7F7F7F7F, 0, 0x7F7F7F7F); } \
        else { _Pragma("unroll") for (int k = 0; k < 2; ++k) acc[ai][bj][m][n] = __builtin_amdgcn_mfma_f32_16x16x32_bf16(__builtin_bit_cast(bf16x8, Bt[n][k]), __builtin_bit_cast(bf16x8, At[m][k]), acc[ai][bj][m][n], 0, 0, 0); } } __builtin_amdgcn_s_setprio(0); } while (0)
#define PG8_WAIT_V(n) asm volatile("s_waitcnt vmcnt(" #n ")" ::: "memory")
#define PG8_WAIT_L(n) asm volatile("s_waitcnt lgkmcnt(" #n ")" ::: "memory")
#define PG8_BAR __builtin_amdgcn_s_barrier()
#define PG8_SCHED __builtin_amdgcn_sched_barrier(0)
    Unit cur, nxt; int ui = 0;
    if (!S.next(0, cur)) return;
    f32x4 acc[2][2][4][2];
#pragma unroll
    for (int a = 0; a < 2; ++a)
#pragma unroll
        for (int b = 0; b < 2; ++b)
#pragma unroll
            for (int m = 0; m < 4; ++m)
#pragma unroll
                for (int n = 0; n < 2; ++n) acc[a][b][m][n] = (f32x4){0.f, 0.f, 0.f, 0.f};
    v4i32 At[4][2], B0[2][2], B1[2][2];
    const char* cA = (const char*)g.A + (size_t)cur.pm * tstep; const char* cB = (const char*)g.Bt + (size_t)cur.pn * tstep;
    S.a_ready(cur);
    if constexpr (SP2) {
        PG8_STAGE(PG8_SB(0, 0), cB, voffB); PG8_STAGE(PG8_SB(0, 1), cB + hstep, voffB); PG8_STAGE(PG8_SA(0, 0), cA, voffA); PG8_STAGE(PG8_SA(0, 1), cA + hstep, voffA);
        if (wr == 1) PG8_BAR;
        PG8_WAIT_V(2); PG8_BAR;
        PG8_STAGE(PG8_SB(1, 0), cB + kstep, voffB); PG8_STAGE(PG8_SA(1, 0), cA + kstep, voffA); PG8_STAGE(PG8_SB(1, 1), cB + hstep + kstep, voffB);
        PG8_WAIT_V(6); PG8_BAR;
    } else {
        PG8_STAGE(PG8_SB(0, 0), cB, voffB); PG8_STAGE(PG8_SA(0, 0), cA, voffA); PG8_STAGE(PG8_SB(0, 1), cB + hstep, voffB); PG8_STAGE(PG8_SA(0, 1), cA + hstep, voffA);
        if (wr == 1) PG8_BAR;
        PG8_WAIT_V(4); PG8_BAR;
        PG8_STAGE(PG8_SB(1, 0), cB + kstep, voffB); PG8_STAGE(PG8_SA(1, 0), cA + kstep, voffA); PG8_STAGE(PG8_SB(1, 1), cB + hstep + kstep, voffB);
        PG8_WAIT_V(6); PG8_BAR;
    }
    for (;;) {
        const bool has_next = S.next(ui + 1, nxt);
        const char* nA = has_next ? (const char*)g.A + (size_t)nxt.pm * tstep : cA; const char* nB = has_next ? (const char*)g.Bt + (size_t)nxt.pn * tstep : cB;
#pragma unroll 1
        for (int t = 0; t < nt; t += 2) {
            const bool last = (t == nt - 2);
            const char* a1 = cA + (size_t)(t + 1) * kstep;
            const char* a2 = last ? nA : cA + (size_t)(t + 2) * kstep; const char* b2 = last ? nB : cB + (size_t)(t + 2) * kstep;
            const char* a3 = a2 + kstep; const char* b3 = b2 + kstep;
            if (last && has_next) S.a_ready(nxt);
            if constexpr (SP2) {
            PG8_LDB(B0, 0, 0); PG8_LDB(B1, 0, 1); PG8_SCHED; PG8_LDA(At, 0, 0); PG8_STAGE(PG8_SA(1, 1), a1 + hstep, voffA);
            PG8_WAIT_V(8); PG8_WAIT_L(0); PG8_BAR; PG8_MMA(0, 0, At, B0); PG8_MMA(0, 1, At, B1); PG8_BAR; PG8_SCHED;
            PG8_LDA(At, 0, 1); PG8_STAGE(PG8_SB(0, 0), b2, voffB); PG8_STAGE(PG8_SB(0, 1), b2 + hstep, voffB); PG8_STAGE(PG8_SA(0, 0), a2, voffA);
            PG8_WAIT_V(8); PG8_WAIT_L(0); PG8_BAR; PG8_MMA(1, 0, At, B0); PG8_MMA(1, 1, At, B1); PG8_BAR; PG8_SCHED;
            PG8_LDB(B0, 1, 0); PG8_LDB(B1, 1, 1); PG8_SCHED; PG8_LDA(At, 1, 0); PG8_STAGE(PG8_SA(0, 1), a2 + hstep, voffA);
            PG8_WAIT_V(8); PG8_WAIT_L(0); PG8_BAR; PG8_MMA(0, 0, At, B0); PG8_MMA(0, 1, At, B1); PG8_BAR; PG8_SCHED;
            PG8_LDA(At, 1, 1); PG8_STAGE(PG8_SB(1, 0), b3, voffB); PG8_STAGE(PG8_SB(1, 1), b3 + hstep, voffB); PG8_STAGE(PG8_SA(1, 0), a3, voffA);
            PG8_WAIT_V(8); PG8_WAIT_L(0); PG8_BAR; PG8_MMA(1, 0, At, B0); PG8_MMA(1, 1, At, B1); PG8_BAR; PG8_SCHED;
            } else {
            PG8_LDB(B0, 0, 0); PG8_SCHED; PG8_LDA(At, 0, 0); PG8_STAGE(PG8_SA(1, 1), a1 + hstep, voffA);
            PG8_WAIT_L(8); PG8_BAR; PG8_WAIT_L(0); PG8_MMA(0, 0, At, B0); PG8_BAR; PG8_SCHED;
            PG8_LDB(B1, 0, 1); PG8_STAGE(PG8_SB(0, 0), b2, voffB);
            PG8_BAR; PG8_WAIT_L(0); PG8_MMA(0, 1, At, B1); PG8_BAR;
            PG8_LDA(At, 0, 1); PG8_STAGE(PG8_SA(0, 0), a2, voffA);
            PG8_BAR; PG8_WAIT_L(0); PG8_MMA(1, 0, At, B0); PG8_BAR; PG8_SCHED;
            PG8_STAGE(PG8_SB(0, 1), b2 + hstep, voffB);
            PG8_WAIT_V(6); PG8_BAR; PG8_MMA(1, 1, At, B1); PG8_BAR;
            PG8_LDB(B0, 1, 0); PG8_SCHED; PG8_LDA(At, 1, 0); PG8_STAGE(PG8_SA(0, 1), a2 + hstep, voffA);
            PG8_WAIT_L(8); PG8_BAR; PG8_WAIT_L(0); PG8_MMA(0, 0, At, B0); PG8_BAR; PG8_SCHED;
            PG8_LDB(B1, 1, 1); PG8_STAGE(PG8_SB(1, 0), b3, voffB);
            PG8_BAR; PG8_WAIT_L(0); PG8_MMA(0, 1, At, B1); PG8_BAR;
            PG8_LDA(At, 1, 1); PG8_STAGE(PG8_SA(1, 0), a3, voffA);
            PG8_BAR; PG8_WAIT_L(0); PG8_MMA(1, 0, At, B0); PG8_BAR; PG8_SCHED;
            PG8_STAGE(PG8_SB(1, 1), b3 + hstep, voffB);
            PG8_WAIT_V(6); PG8_BAR; PG8_MMA(1, 1, At, B1); PG8_BAR;
            }
        }
        if constexpr (ALIGN_EPI) { if (wr == 0) PG8_BAR; }
        if constexpr (!Epi::AFTER_DRAIN) { E(acc, cur, wr, wc, fr, fq); S.done(cur); }
        if (!has_next) break;
#pragma unroll
        for (int a = 0; a < 2; ++a)
#pragma unroll
            for (int b = 0; b < 2; ++b)
#pragma unroll
                for (int m = 0; m < 4; ++m)
#pragma unroll
                    for (int n = 0; n < 2; ++n) acc[a][b][m][n] = (f32x4){0.f, 0.f, 0.f, 0.f};
        cur = nxt; cA = nA; cB = nB; ++ui;
        if constexpr (ALIGN_EPI) { if (wr == 1) PG8_BAR; }
    }
    PG8_WAIT_V(0);
    if constexpr (!ALIGN_EPI) { if (wr == 0) PG8_BAR; }
    PG8_BAR;
    if constexpr (Epi::AFTER_DRAIN) { E.fused(acc, cur, wr, wc, fr, fq, lds, wid, lane); S.done(cur); }
#undef PG8_SA
#undef PG8_SB
#undef PG8_STAGE
#undef PG8_GLDS
#undef PG8_LDA
#undef PG8_LDB
#undef PG8_MMA
#undef PG8_CAT
#undef PG8_WAIT_V
#undef PG8_WAIT_L
#undef PG8_BAR
#undef PG8_SCHED
}
}
namespace cg = cooperative_groups;
#define LAS __attribute__((address_space(3)))
typedef unsigned short bf16_t;
typedef short bf16x8 __attribute__((ext_vector_type(8)));
typedef short s16x4 __attribute__((ext_vector_type(4)));
typedef short v4i16_t __attribute__((ext_vector_type(4)));
typedef float f32x4 __attribute__((ext_vector_type(4)));
typedef float f32x16 __attribute__((ext_vector_type(16)));
typedef unsigned u32x4 __attribute__((ext_vector_type(4)));
typedef unsigned u32x2 __attribute__((ext_vector_type(2)));

constexpr int NWAVES = 8, NTHR = 512;
constexpr int D = 1024, SEQ = 2048, NBATCH = 32, FF = 2816, NPROJ = 3072;
constexpr int MP = 65536, MS = 128, MV = MP + MS, MPAD = 65792;
constexpr float EPS = 1e-6f;
constexpr int LDS_BYTES = 147456;
constexpr size_t O_Y = 0, O_KP = 67239936, O_VP = O_KP + 33554432, O_CP = O_VP + 33554432, O_NP = O_CP + 1048576, O_MPR = O_NP + 8192,
                 O_KS = O_MPR + 128, O_VS = O_KS + 65536, O_CS = O_VS + 65536, O_NS = O_CS + 262144, O_MS = O_NS + 2048, O_END = O_MS + 32;
constexpr size_t MiB = 1u << 20;
constexpr size_t WS_CTL = 0, WS_MOD = 1 * MiB, WS_ROPE = 3 * MiB, WS_GATES = 4 * MiB, WS_W1I = 8 * MiB, WS_W1O = 20 * MiB, WS_WIN = 26 * MiB, WS_WO = 32 * MiB,
                 WS_W2I = 34 * MiB, WS_W2O = 46 * MiB, WS_SK = 52 * MiB, WS_SV = 61 * MiB, WS_H = 72 * MiB, WS_F = 202 * MiB, WS_P = 332 * MiB, WS_W1I8 = 720 * MiB, WS_W2I8 = 726 * MiB, WS_W2O8 = 732 * MiB, WS_X16 = 736 * MiB, WS_END = 866 * MiB;
constexpr float H8_SCALE = 8.0f, W8_SCALE = 256.0f, A8_SCALE = 4.0f;

typedef float f32x2c __attribute__((ext_vector_type(2))); typedef __bf16 bf16x2c __attribute__((ext_vector_type(2)));
__device__ __forceinline__ unsigned pk2(float lo, float hi) { const f32x2c v = {lo, hi}; return __builtin_bit_cast(unsigned, __builtin_convertvector(v, bf16x2c)); }
__device__ __forceinline__ unsigned f2bf(float f) { return pk2(f, f) & 0xffffu; }
__device__ __forceinline__ float bflo(unsigned u) { return __uint_as_float(u << 16); }
__device__ __forceinline__ float bfhi(unsigned u) { return __uint_as_float(u & 0xffff0000u); }
__device__ __forceinline__ float wave_sum(float v) {
#pragma unroll
    for (int o = 1; o < 64; o <<= 1) v += __shfl_xor(v, o);
    return v;
}
__device__ __forceinline__ int crow(int r, int hi) { return (r & 3) + 8 * (r >> 2) + 4 * hi; }

struct Args { const float* in[23]; float* out; unsigned char* ws; int ph_lo, ph_hi; };

__device__ __forceinline__ unsigned pk4_fp8(float a, float b, float c, float d) { unsigned p = 0u; p = __builtin_amdgcn_cvt_pk_fp8_f32(a, b, p, false); p = __builtin_amdgcn_cvt_pk_fp8_f32(c, d, p, true); return p; }
__device__ __forceinline__ void p0_transpose_item(const float* W, int K, int N, bf16_t* WT, int k0, int sc0, int dr0, LAS float* scr, int lane, unsigned char* WT8 = nullptr) {
    float wv[32];
#pragma unroll
    for (int i = 0; i < 32; ++i) wv[i] = W[(size_t)(k0 + 2 * i + (lane >> 5)) * N + sc0 + (lane & 31)];
#pragma unroll
    for (int i = 0; i < 32; ++i) scr[(2 * i + (lane >> 5)) * 33 + (lane & 31)] = wv[i];
    asm volatile("s_waitcnt lgkmcnt(0)" ::: "memory");
    const int c = lane & 7;
#pragma unroll
    for (int j = 0; j < 4; ++j) { const int n = (lane >> 3) + 8 * j; const LAS float* s = scr + (8 * c) * 33 + n;
        u32x4 o; o.x = pk2(s[0 * 33], s[1 * 33]); o.y = pk2(s[2 * 33], s[3 * 33]); o.z = pk2(s[4 * 33], s[5 * 33]); o.w = pk2(s[6 * 33], s[7 * 33]);
        *(u32x4*)(WT + (size_t)(dr0 + n) * K + k0 + 8 * c) = o; }
    if (WT8) {
        const int c4 = lane & 3;
#pragma unroll
        for (int j = 0; j < 2; ++j) { const int n = (lane >> 2) + 16 * j; const LAS float* s = scr + (16 * c4) * 33 + n;
            u32x4 o; o.x = pk4_fp8(s[0] * W8_SCALE, s[33] * W8_SCALE, s[66] * W8_SCALE, s[99] * W8_SCALE); o.y = pk4_fp8(s[132] * W8_SCALE, s[165] * W8_SCALE, s[198] * W8_SCALE, s[231] * W8_SCALE);
            o.z = pk4_fp8(s[264] * W8_SCALE, s[297] * W8_SCALE, s[330] * W8_SCALE, s[363] * W8_SCALE); o.w = pk4_fp8(s[396] * W8_SCALE, s[429] * W8_SCALE, s[462] * W8_SCALE, s[495] * W8_SCALE);
            *(u32x4*)(WT8 + (size_t)(dr0 + n) * K + k0 + 16 * c4) = o; }
    }
    asm volatile("s_waitcnt lgkmcnt(0)" ::: "memory");
}
__device__ __forceinline__ int ffn_in_src(int dr0) { const int tile = dr0 >> 8, w0 = dr0 & 255; return (w0 < 128) ? (128 * tile + w0) : (FF + 128 * tile + w0 - 128); }

__device__ __forceinline__ void p0_prologue(const Args& a, LAS unsigned char* lds) {
    int tid = threadIdx.x; asm volatile("" : "+v"(tid));
    const int lane = tid & 63, wave = __builtin_amdgcn_readfirstlane(tid >> 6);
    const int G = gridDim.x;
    unsigned char* ws = a.ws;
    if (blockIdx.x == 0 && wave == 0) {
        const float* lq = a.in[19];
        float a0 = lq[lane] * lq[64 + lane], a1 = lq[128 + lane] * lq[192 + lane];
        a0 = wave_sum(a0); a1 = wave_sum(a1);
        if (lane == 0) { ((float*)(ws + WS_CTL))[64] = __expf(a0) - __expf(a1) + 0.2f; }
    }
    {
        const float* cp = a.in[7]; const float* csm = a.in[8]; const float* wada = a.in[9]; const float* bada = a.in[10];
        float* mod = (float*)(ws + WS_MOD);
        LAS float* sct = (LAS float*)lds;
        LAS float* red = (LAS float*)(lds + 81920);
        for (int it = blockIdx.x; it < 576; it += G) {
            const int cgp = it >> 1, rh = it & 1;
            for (int i = tid; i < 20480; i += NTHR) { const int rr = i >> 10, k = i & 1023, grow = 20 * rh + rr;
                const float c = grow < 32 ? cp[grow * 1024 + k] : csm[(grow - 32) * 1024 + k];
                sct[k * 20 + rr] = c * __builtin_amdgcn_rcpf(1.0f + __expf(-c)); }
            __syncthreads();
            const int col = tid & 31, ks = tid >> 5;
            float acc[20];
#pragma unroll
            for (int r = 0; r < 20; ++r) acc[r] = 0.f;
            const float* wp = wada + (size_t)(64 * ks) * 9216 + 32 * cgp + col;
            float wv[64];
#pragma unroll
            for (int kk = 0; kk < 64; ++kk) wv[kk] = wp[(size_t)kk * 9216];
#pragma unroll
            for (int kk = 0; kk < 64; ++kk) {
                const float w = wv[kk];
                const LAS f32x4* s4 = (const LAS f32x4*)(sct + (64 * ks + kk) * 20);
#pragma unroll
                for (int q = 0; q < 5; ++q) { const f32x4 s = s4[q]; acc[4 * q] += s[0] * w; acc[4 * q + 1] += s[1] * w; acc[4 * q + 2] += s[2] * w; acc[4 * q + 3] += s[3] * w; }
            }
#pragma unroll
            for (int r = 0; r < 20; ++r) red[(ks * 20 + r) * 32 + col] = acc[r];
            __syncthreads();
            for (int i = tid; i < 640; i += NTHR) { const int r = i >> 5, c2 = i & 31; float s = bada[32 * cgp + c2];
#pragma unroll
                for (int k2 = 0; k2 < 16; ++k2) s += red[(k2 * 20 + r) * 32 + c2];
                mod[(size_t)(20 * rh + r) * 9216 + 32 * cgp + c2] = s; }
            __syncthreads();
        }
    }
    {
        LAS float* scr = (LAS float*)(lds + wave * 16384);
        const int gw = blockIdx.x * NWAVES + wave, NGW = G * NWAVES;
        constexpr int I_1I = 16 * 176, I_1O = 44 * 32, I_IN = 16 * 96, I_O = 16 * 32;
        constexpr int NITEMS = 2 * I_1I + 2 * I_1O + I_IN + I_O;
        for (int it = gw; it < NITEMS; it += NGW) {
            int r = it;
            if (r < I_1I) { const int kb = r / 176, nb = r % 176; p0_transpose_item(a.in[12], D, 2 * FF, (bf16_t*)(ws + WS_W1I), 64 * kb, ffn_in_src(32 * nb), 32 * nb, scr, lane); continue; } r -= I_1I;
            if (r < I_1I) { const int kb = r / 176, nb = r % 176; p0_transpose_item(a.in[21], D, 2 * FF, (bf16_t*)(ws + WS_W2I), 64 * kb, ffn_in_src(32 * nb), 32 * nb, scr, lane, ws + WS_W2I8); continue; } r -= I_1I;
            if (r < I_1O) { const int kb = r / 32, nb = r % 32; p0_transpose_item(a.in[13], FF, D, (bf16_t*)(ws + WS_W1O), 64 * kb, 32 * nb, 32 * nb, scr, lane); continue; } r -= I_1O;
            if (r < I_1O) { const int kb = r / 32, nb = r % 32; p0_transpose_item(a.in[22], FF, D, (bf16_t*)(ws + WS_W2O), 64 * kb, 32 * nb, 32 * nb, scr, lane, ws + WS_W2O8); continue; } r -= I_1O;
            if (r < I_IN) { const int kb = r / 96, nb = r % 96; p0_transpose_item(a.in[14], D, 3080, (bf16_t*)(ws + WS_WIN), 64 * kb, 32 * nb + (nb >= 48 ? 8 : 0), 32 * nb, scr, lane); continue; } r -= I_IN;
            { const int kb = r / 32, nb = r % 32; p0_transpose_item(a.in[20], D, D, (bf16_t*)(ws + WS_WO), 64 * kb, 32 * nb, 32 * nb, scr, lane); }
        }
    }
    {
        const int gt = blockIdx.x * NTHR + tid, NGT = G * NTHR;
        for (int i = gt; i < 2 * 524288; i += NGT) {
            const int ten = i >> 19, j = i & 524287, b = j >> 16, rem = j & 65535, pos = rem >> 6, ch = rem & 63;
            const float* src = a.in[2 + ten] + ((size_t)(b * 1024 + pos) * 512 + ch * 8);
            const f32x4 x0 = *(const f32x4*)src, x1 = *(const f32x4*)(src + 4);
            u32x4 o; o.x = pk2(x0[0], x0[1]); o.y = pk2(x0[2], x0[3]); o.z = pk2(x1[0], x1[1]); o.w = pk2(x1[2], x1[3]);
            *(u32x4*)((bf16_t*)(ws + (ten ? WS_SV : WS_SK)) + ((size_t)(b * 1088 + pos) * 512 + ch * 8)) = o;
        }
        float* rope = (float*)(ws + WS_ROPE);
        for (int i = gt; i < 2048 * 8; i += NGT) {
            const int pos = i >> 3, fi = i & 7;
            const double invf = fi == 0 ? 1.0 : fi == 1 ? 0.19392274474868576 : fi == 2 ? 0.03760603093086393 : fi == 3 ? 0.007292664737217109 : fi == 4 ? 0.001414213562373095
                              : fi == 5 ? 0.0002742481756762073 : fi == 6 ? 5.318295896944988e-05 : 1.031338537721246e-05;
            const double ang = (double)pos * invf;
            const double n = __builtin_rint(ang * 0.15915494309189535);
            const double rr = __builtin_fma(-n, 6.283185307179586, ang);
            const double kq = __builtin_rint(rr * 0.6366197723675814);
            const double y = __builtin_fma(-kq, 1.5707963267948966, rr), y2 = y * y;
            const double sn = y * (1.0 - y2 / 6.0 * (1.0 - y2 / 20.0 * (1.0 - y2 / 42.0 * (1.0 - y2 / 72.0 * (1.0 - y2 / 110.0 * (1.0 - y2 / 156.0))))));
            const double cs = 1.0 - y2 / 2.0 * (1.0 - y2 / 12.0 * (1.0 - y2 / 30.0 * (1.0 - y2 / 56.0 * (1.0 - y2 / 90.0 * (1.0 - y2 / 132.0)))));
            const int q = ((int)kq) & 3;
            const double c = q == 0 ? cs : q == 1 ? -sn : q == 2 ? -cs : sn;
            const double s = q == 0 ? sn : q == 1 ? cs : q == 2 ? -sn : -cs;
            rope[pos * 16 + fi] = (float)c; rope[pos * 16 + 8 + fi] = (float)s;
        }
    }
}

template <bool HAS_F, bool HAS_H, bool GATES, bool H8 = false  , bool XIN16 = false, bool XOUT16 = false  >
__device__ __forceinline__ void row_phase(const Args& a, LAS unsigned char* lds, const float* xin_p, const float* xin_s, float* xout, int kg, float rw, int gpost, int gpre, int ksh, int ksc) {
    int tid = threadIdx.x; asm volatile("" : "+v"(tid));
    const int lane = tid & 63, wave = __builtin_amdgcn_readfirstlane(tid >> 6);
    const int gw = blockIdx.x * NWAVES + wave, NGW = gridDim.x * NWAVES;
    unsigned char* ws = a.ws;
    const float* mod = (const float*)(ws + WS_MOD);
    const float* gn = a.in[11];
    const bf16_t* F = (const bf16_t*)(ws + WS_F);
    bf16_t* H = (bf16_t*)(ws + WS_H); bf16_t* X16 = (bf16_t*)(ws + WS_X16);
    float* gates = (float*)(ws + WS_GATES);
    LAS float* wg = (LAS float*)lds;
    if (GATES) {
        const float* win = a.in[14];
        for (int i = tid; i < 8192; i += NTHR) wg[i] = win[(size_t)(i >> 3) * 3080 + 1536 + (i & 7)];
        __syncthreads();
    }
    if (HAS_H && !HAS_F) {
        for (int i = blockIdx.x * NTHR + tid; i < (MPAD - MV) * D / 8; i += gridDim.x * NTHR) *(u32x4*)(H + (size_t)MV * D + (size_t)i * 8) = (u32x4){0u, 0u, 0u, 0u};
    }
    for (int ch = gw; ch < 2048 + MS; ch += NGW) {
        const bool samp = ch >= 2048;
        const int row0 = samp ? MP + (ch - 2048) : ch * 32, nrows = samp ? 1 : 32;
        const int mb = samp ? 32 + ((ch - 2048) >> 4) : (ch >> 6);
        const float* mrow = mod + (size_t)mb * 9216;
        f32x4 A1[4], A2[4], A3[4];
#pragma unroll
        for (int j = 0; j < 4; ++j) {
            const int e = 4 * lane + 256 * j;
            if (HAS_F && !GATES) { const f32x4 mg = *(const f32x4*)(mrow + kg * 1024 + e), gp = *(const f32x4*)(gn + gpost * 1024 + e); A1[j] = mg * gp * rw; }
            if (HAS_H) { const f32x4 gp = *(const f32x4*)(gn + gpre * 1024 + e), sc = *(const f32x4*)(mrow + ksc * 1024 + e); A2[j] = gp * (sc + 1.0f); if (!GATES) A3[j] = *(const f32x4*)(mrow + ksh * 1024 + e); }
        }
        for (int rr = 0; rr < nrows; ++rr) {
            const int row = row0 + rr;
            const float* xr = samp ? xin_s + (size_t)(row - MP) * D : xin_p + (size_t)row * D;
            f32x4 x[4];
#pragma unroll
            for (int j = 0; j < 4; ++j) {
                if (XIN16) { const u32x2 u = *(const u32x2*)(X16 + (size_t)row * D + 4 * lane + 256 * j); x[j] = (f32x4){bflo(u.x), bfhi(u.x), bflo(u.y), bfhi(u.y)}; }
                else x[j] = *(const f32x4*)(xr + 4 * lane + 256 * j);
            }
            if (HAS_F) {
                f32x4 f[4]; float ss = 0.f;
#pragma unroll
                for (int j = 0; j < 4; ++j) { const u32x2 u = *(const u32x2*)(F + (size_t)row * D + 4 * lane + 256 * j);
                    f[j] = (f32x4){bflo(u.x), bfhi(u.x), bflo(u.y), bfhi(u.y)}; ss += (f[j][0] * f[j][0] + f[j][1] * f[j][1]) + (f[j][2] * f[j][2] + f[j][3] * f[j][3]); }
                const float rstd = __builtin_amdgcn_rsqf(wave_sum(ss) * (1.0f / D) + EPS);
#pragma unroll
                for (int j = 0; j < 4; ++j) { f32x4 a1; if (GATES) { const int e = 4 * lane + 256 * j; a1 = *(const f32x4*)(mrow + kg * 1024 + e) * *(const f32x4*)(gn + gpost * 1024 + e) * rw; } else a1 = A1[j];
                    x[j] = x[j] + a1 * f[j] * rstd;
                    if (XOUT16) { u32x2 o; o.x = pk2(x[j][0], x[j][1]); o.y = pk2(x[j][2], x[j][3]); *(u32x2*)(X16 + (size_t)row * D + 4 * lane + 256 * j) = o; }
                    else *(f32x4*)(xout + (size_t)row * D + 4 * lane + 256 * j) = x[j]; }
            }
            if (HAS_H) {
                float ss = 0.f;
#pragma unroll
                for (int j = 0; j < 4; ++j) ss += (x[j][0] * x[j][0] + x[j][1] * x[j][1]) + (x[j][2] * x[j][2] + x[j][3] * x[j][3]);
                const float rstd = __builtin_amdgcn_rsqf(wave_sum(ss) * (1.0f / D) + EPS);
                f32x4 h[4];
#pragma unroll
                for (int j = 0; j < 4; ++j) { const f32x4 sh = GATES ? *(const f32x4*)(mrow + ksh * 1024 + 4 * lane + 256 * j) : A3[j]; h[j] = x[j] * rstd * A2[j] + sh;
                    if (H8 && !samp) { *(unsigned*)((unsigned char*)H + (size_t)row * D + 4 * lane + 256 * j) = pk4_fp8(h[j][0] * H8_SCALE, h[j][1] * H8_SCALE, h[j][2] * H8_SCALE, h[j][3] * H8_SCALE); }
                    else { u32x2 o; o.x = pk2(h[j][0], h[j][1]); o.y = pk2(h[j][2], h[j][3]); *(u32x2*)(H + (size_t)row * D + 4 * lane + 256 * j) = o; } }
                if (GATES) {
                    float g[8];
#pragma unroll
                    for (int q = 0; q < 8; ++q) g[q] = 0.f;
#pragma unroll
                    for (int j = 0; j < 4; ++j)
#pragma unroll
                        for (int e = 0; e < 4; ++e) { const LAS f32x4* wp = (const LAS f32x4*)(wg + (4 * lane + 256 * j + e) * 8); const f32x4 w0 = wp[0], w1 = wp[1]; const float hv = h[j][e];
                            g[0] += hv * w0[0]; g[1] += hv * w0[1]; g[2] += hv * w0[2]; g[3] += hv * w0[3]; g[4] += hv * w1[0]; g[5] += hv * w1[1]; g[6] += hv * w1[2]; g[7] += hv * w1[3]; }
#pragma unroll
                    for (int q = 0; q < 8; ++q) g[q] = wave_sum(g[q]);
                    const float gsel = lane == 0 ? g[0] : lane == 1 ? g[1] : lane == 2 ? g[2] : lane == 3 ? g[3] : lane == 4 ? g[4] : lane == 5 ? g[5] : lane == 6 ? g[6] : g[7];
                    if (lane < 8) {
                        float v;
                        if (lane < 4) v = gsel + a.in[15][lane];
                        else { const float z = gsel + a.in[16][lane - 4]; v = fminf(z, 0.f) - log1pf(__expf(-fabsf(z))); }
                        gates[(size_t)row * 8 + lane] = v;
                    }
                }
            }
        }
    }
}
typedef LAS unsigned char* ldsp;
__device__ __forceinline__ bf16x8 lds_frag(ldsp p) { return *(const LAS bf16x8*)p; }
__device__ __forceinline__ s16x4 vtr(ldsp p) { return __builtin_bit_cast(s16x4, __builtin_amdgcn_ds_read_tr16_b64_v4i16((LAS v4i16_t*)p)); }
__device__ __forceinline__ bf16x8 vtr2(ldsp p) { const s16x4 lo = vtr(p), hi = vtr(p + 512); return (bf16x8){lo[0], lo[1], lo[2], lo[3], hi[0], hi[1], hi[2], hi[3]}; }
__device__ __forceinline__ bf16x8 pack8(const f32x16& p, int s) {
    u32x4 w; w.x = pg8::cvt_pk_bf16(p[8 * s + 0], p[8 * s + 1]); w.y = pg8::cvt_pk_bf16(p[8 * s + 2], p[8 * s + 3]); w.z = pg8::cvt_pk_bf16(p[8 * s + 4], p[8 * s + 5]); w.w = pg8::cvt_pk_bf16(p[8 * s + 6], p[8 * s + 7]);
    return __builtin_bit_cast(bf16x8, w);
}
__device__ __forceinline__ int rimg(int row, int c, int nrows) { return c * nrows * 16 + ((row ^ (c & 7)) * 16); }
__device__ __forceinline__ int timg(int s, int c16) { return (c16 >> 2) * 4096 + (s >> 3) * 512 + (s & 7) * 64 + (c16 & 3) * 16; }

constexpr float LOG2E = 1.4426950408889634f;
__device__ __forceinline__ float max3f(float a, float b, float c) { float r; asm("v_max3_f32 %0, %1, %2, %3" : "=v"(r) : "v"(a), "v"(b), "v"(c)); return r; }
constexpr float AT_THR = 8.0f;
constexpr int AT_Q = 0, AT_KV = 32768, AT_KVB = 32768, AT_V = 16384, AT_X = 0;

__device__ __forceinline__ void attn_unit(ldsp lds, const bf16_t* Qg, int qstride, int nq_valid, const bf16_t* Kg, const bf16_t* Vg, int kvstride, int NT, int lim, int nvalid_last,
                                          bf16_t* Og, const float* gd, float lam) {
    int tid = threadIdx.x; asm volatile("" : "+v"(tid));
    const int lane = tid & 63, w = __builtin_amdgcn_readfirstlane(tid >> 6), r32 = lane & 31, hi = lane >> 5;
    const int rg = w >> 1, c = w & 1;
#pragma unroll
    for (int i = 0; i < 4; ++i) { const int id = tid + NTHR * i, row = id >> 4, c16 = id & 15, srow = row < nq_valid ? row : 0;
        const u32x4 v = *(const u32x4*)(Qg + (size_t)srow * qstride + c16 * 8);
        *(LAS u32x4*)(lds + AT_Q + rimg(row, c16, 128)) = v; }
    const int key0 = tid >> 4, cc = tid & 15;
    const bf16_t* kp = Kg + (size_t)key0 * kvstride + cc * 8; const bf16_t* vp = Vg + (size_t)key0 * kvstride + cc * 8;
    u32x4 kr0, kr1, vr0, vr1;
    kr0 = *(const u32x4*)kp; kr1 = *(const u32x4*)(kp + (size_t)32 * kvstride); vr0 = *(const u32x4*)vp; vr1 = *(const u32x4*)(vp + (size_t)32 * kvstride);
    f32x16 O[4];
#pragma unroll
    for (int d = 0; d < 4; ++d)
#pragma unroll
        for (int r = 0; r < 16; ++r) O[d][r] = 0.f;
    float lrun = 0.f;
    f32x16 negm;
#pragma unroll
    for (int r = 0; r < 16; ++r) negm[r] = 0.f;
    const int vlane = ((lane >> 4) & 1) * 32 + (lane & 3) * 8 + (4 * hi + ((lane & 15) >> 2)) * 64;
    for (int j = 0; j < NT; ++j) {
        const ldsp kb = lds + AT_KV + (j & 1) * AT_KVB; const ldsp vb = kb + AT_V;
        *(LAS u32x4*)(kb + rimg(key0, cc, 64)) = kr0; *(LAS u32x4*)(kb + rimg(key0 + 32, cc, 64)) = kr1;
        *(LAS u32x4*)(vb + timg(key0, cc)) = vr0; *(LAS u32x4*)(vb + timg(key0 + 32, cc)) = vr1;
        __syncthreads();
        if (j + 1 < NT) { const size_t o = (size_t)(64 * (j + 1)) * kvstride;
            kr0 = *(const u32x4*)(kp + o); kr1 = *(const u32x4*)(kp + o + (size_t)32 * kvstride); vr0 = *(const u32x4*)(vp + o); vr1 = *(const u32x4*)(vp + o + (size_t)32 * kvstride); }
        if (j <= lim) {
            const bool maskt = (j == NT - 1) && (nvalid_last < 64);
            f32x16 s0 = negm, s1 = negm;
#pragma unroll
            for (int st = 0; st < 4; ++st) {
                const int c16 = 8 * c + 2 * st + hi;
                const bf16x8 qf = lds_frag(lds + AT_Q + rimg(32 * rg + r32, c16, 128));
                const bf16x8 k0 = lds_frag(kb + rimg(r32, c16, 64)), k1 = lds_frag(kb + rimg(32 + r32, c16, 64));
                s0 = __builtin_amdgcn_mfma_f32_32x32x16_bf16(k0, qf, s0, 0, 0, 0);
                s1 = __builtin_amdgcn_mfma_f32_32x32x16_bf16(k1, qf, s1, 0, 0, 0);
            }
            if (maskt) {
#pragma unroll
                for (int r = 0; r < 16; ++r) { const int key = crow(r, hi); if (key >= nvalid_last) s0[r] = -INFINITY; if (key + 32 >= nvalid_last) s1[r] = -INFINITY; }
            }
            float mx = -INFINITY;
#pragma unroll
            for (int r = 0; r < 16; ++r) mx = max3f(mx, s0[r], s1[r]);
            mx = fmaxf(mx, __shfl_xor(mx, 32));
            if (j == 0 || __builtin_amdgcn_ballot_w64(mx > AT_THR) != 0ull) {
                const float delta = (j == 0) ? mx : fmaxf(mx, 0.f);
                const float alpha = (j == 0) ? 1.0f : __builtin_amdgcn_exp2f(-delta);
                lrun *= alpha;
#pragma unroll
                for (int r = 0; r < 16; ++r) { negm[r] -= delta; s0[r] -= delta; s1[r] -= delta; }
#pragma unroll
                for (int d = 0; d < 4; ++d)
#pragma unroll
                    for (int r = 0; r < 16; ++r) O[d][r] *= alpha;
            }
            float rs = 0.f;
#pragma unroll
            for (int r = 0; r < 16; ++r) { s0[r] = __builtin_amdgcn_exp2f(s0[r]); s1[r] = __builtin_amdgcn_exp2f(s1[r]); rs += s0[r] + s1[r]; }
            rs += __shfl_xor(rs, 32);
            lrun += rs;
            const bf16x8 pf0 = pack8(s0, 0), pf1 = pack8(s0, 1), pf2 = pack8(s1, 0), pf3 = pack8(s1, 1);
#pragma unroll
            for (int d = 0; d < 4; ++d) {
                const ldsp vq = vb + vlane + d * 4096;
                O[d] = __builtin_amdgcn_mfma_f32_32x32x16_bf16(vtr2(vq), pf0, O[d], 0, 0, 0);
                O[d] = __builtin_amdgcn_mfma_f32_32x32x16_bf16(vtr2(vq + 1024), pf1, O[d], 0, 0, 0);
                O[d] = __builtin_amdgcn_mfma_f32_32x32x16_bf16(vtr2(vq + 2048), pf2, O[d], 0, 0, 0);
                O[d] = __builtin_amdgcn_mfma_f32_32x32x16_bf16(vtr2(vq + 3072), pf3, O[d], 0, 0, 0);
            }
        }
    }
    __syncthreads();
    LAS float* xch = (LAS float*)(lds + AT_X) + rg * 4096 + lane;
    if (lim >= 0 && c == 1) {
        const float i1 = lam / lrun;
#pragma unroll
        for (int d = 0; d < 4; ++d)
#pragma unroll
            for (int r = 0; r < 16; ++r) xch[(d * 16 + r) * 64] = O[d][r] * i1;
    }
    __syncthreads();
    if (lim >= 0 && c == 0) {
        const float i0 = 1.0f / lrun;
        float ss = 0.f;
#pragma unroll
        for (int d = 0; d < 4; ++d)
#pragma unroll
            for (int r = 0; r < 16; ++r) { const float o = O[d][r] * i0 - xch[(d * 16 + r) * 64]; O[d][r] = o; ss += o * o; }
        ss += __shfl_xor(ss, 32);
        const float rstd = __builtin_amdgcn_rsqf(ss * (1.0f / 128.0f) + EPS) * 0.8f;
        const int q = 32 * rg + r32;
        if (q < nq_valid) {
            bf16_t* orow = Og + (size_t)q * D;
#pragma unroll
            for (int d = 0; d < 4; ++d)
#pragma unroll
                for (int g4 = 0; g4 < 4; ++g4) { const int dd = 32 * d + 8 * g4 + 4 * hi; const f32x4 gv = *(const f32x4*)(gd + dd);
                    u32x2 o; o.x = pk2(O[d][4 * g4] * rstd * gv[0], O[d][4 * g4 + 1] * rstd * gv[1]); o.y = pk2(O[d][4 * g4 + 2] * rstd * gv[2], O[d][4 * g4 + 3] * rstd * gv[3]);
                    *(u32x2*)(orow + dd) = o; }
        }
    }
}

constexpr int ML_BUFB = 40960, ML_Q = 0, ML_K = 8192, ML_KT = 16384, ML_V = 24576;
constexpr int ML_C = 81920, ML_A = 98304, ML_G = 106496, ML_B = 114688, ML_MP = 122880, ML_N = 123136, ML_SS = 123392;
__device__ __forceinline__ void mlstm_unit(ldsp lds, const bf16_t* Pb  , const float* gates  , int h, int nch, int ntok,
                                           const float* C0, const float* n0, const float* m0, bf16_t* Hb  , const float* gm  ,
                                           float* Cout, float* nout, float* mout) {
    int tid = threadIdx.x; asm volatile("" : "+v"(tid));
    const int lane = tid & 63, w = __builtin_amdgcn_readfirstlane(tid >> 6), r32 = lane & 31, hi = lane >> 5;
    const int T = nch * 64;
    LAS float* la = (LAS float*)(lds + ML_A); LAS float* lg = (LAS float*)(lds + ML_G); LAS float* lb = (LAS float*)(lds + ML_B);
    LAS float* lmp = (LAS float*)(lds + ML_MP); LAS float* ln = (LAS float*)(lds + ML_N); LAS float* lss = (LAS float*)(lds + ML_SS);
    for (int t = tid; t < T; t += NTHR) { const bool ok = (t & 63) < ntok; const int rowt = (t >> 6) * 64 + (t & 63);
        la[t] = ok ? gates[(size_t)rowt * 8 + h] : -1e30f; lb[t] = ok ? gates[(size_t)rowt * 8 + 4 + h] : 0.f; }
    if (tid < 64) *(LAS bf16_t*)(lds + ML_N + tid * 2) = (bf16_t)f2bf(n0 ? n0[tid] : 0.f);
    __syncthreads();
    if (w == 0) {
        float mcur = m0 ? m0[0] : 0.f;
        for (int c = 0; c < nch; ++c) {
            float b = lb[64 * c + lane];
#pragma unroll
            for (int o = 1; o < 64; o <<= 1) { const float t = __shfl_up(b, o); if (lane >= o) b += t; }
            const float av = la[64 * c + lane] - b;
            float cm = av;
#pragma unroll
            for (int o = 1; o < 64; o <<= 1) { const float t = __shfl_up(cm, o); if (lane >= o) cm = fmaxf(cm, t); }
            const float g = fmaxf(mcur, cm);
            la[64 * c + lane] = av; lg[64 * c + lane] = g; lb[64 * c + lane] = b;
            if (lane == 0) lmp[c] = mcur;
            mcur = __shfl(b + g, 63);
        }
        if (lane == 0) { lmp[nch] = mcur; mout[0] = mcur; }
    }
    const int vb = w >> 1, db = w & 1, tb = w & 1;
    f32x16 Cacc;
    float nreg = n0 ? n0[32 * db + r32] : 0.f;
#pragma unroll
    for (int r = 0; r < 16; ++r) { const int dv = 32 * vb + crow(r, hi), dk = 32 * db + r32; Cacc[r] = C0 ? C0[dv * 64 + dk] : 0.f; }
#pragma unroll
    for (int r = 0; r < 16; ++r) { const int dv = 32 * vb + crow(r, hi), dk = 32 * db + r32; *(LAS bf16_t*)(lds + ML_C + rimg(dv, dk >> 3, 128) + (dk & 7) * 2) = (bf16_t)f2bf(Cacc[r]); }
    const int st = tid >> 3, sc8 = tid & 7, sv0 = tid >> 4, sc16 = tid & 15;
    u32x4 qr, kr, v0r, v1r;
    {
        const bool ok = st < ntok; const bool ok0 = sv0 < ntok, ok1 = sv0 + 32 < ntok; const u32x4 z = {0u, 0u, 0u, 0u};
        qr = ok ? *(const u32x4*)(Pb + (size_t)st * NPROJ + h * 64 + sc8 * 8) : z; kr = ok ? *(const u32x4*)(Pb + (size_t)st * NPROJ + 256 + h * 64 + sc8 * 8) : z;
        v0r = ok0 ? *(const u32x4*)(Pb + (size_t)sv0 * NPROJ + 512 + h * 128 + sc16 * 8) : z; v1r = ok1 ? *(const u32x4*)(Pb + (size_t)(sv0 + 32) * NPROJ + 512 + h * 128 + sc16 * 8) : z;
    }
    __syncthreads();
    const int vlane = ((lane >> 4) & 1) * 32 + (lane & 3) * 8 + (4 * hi + ((lane & 15) >> 2)) * 64;
    for (int c = 0; c < nch; ++c) {
        const ldsp buf = lds + (c & 1) * ML_BUFB;
        {
            const float g63 = lg[64 * c + 63];
            const float wr = __expf(la[64 * c + st] - g63);
            *(LAS u32x4*)(buf + ML_Q + rimg(st, sc8, 64)) = qr; *(LAS u32x4*)(buf + ML_K + rimg(st, sc8, 64)) = kr;
            u32x4 ks; ks.x = pk2(bflo(kr.x) * wr, bfhi(kr.x) * wr); ks.y = pk2(bflo(kr.y) * wr, bfhi(kr.y) * wr); ks.z = pk2(bflo(kr.z) * wr, bfhi(kr.z) * wr); ks.w = pk2(bflo(kr.w) * wr, bfhi(kr.w) * wr);
            *(LAS u32x4*)(buf + ML_KT + timg(st, sc8)) = ks;
            *(LAS u32x4*)(buf + ML_V + timg(sv0, sc16)) = v0r; *(LAS u32x4*)(buf + ML_V + timg(sv0 + 32, sc16)) = v1r;
        }
        __syncthreads();
        const int t = 32 * tb + r32;
        if (c + 1 < nch) {
            const bf16_t* Pn = Pb + (size_t)(64 * (c + 1)) * NPROJ;
            qr = *(const u32x4*)(Pn + (size_t)st * NPROJ + h * 64 + sc8 * 8); kr = *(const u32x4*)(Pn + (size_t)st * NPROJ + 256 + h * 64 + sc8 * 8);
            v0r = *(const u32x4*)(Pn + (size_t)sv0 * NPROJ + 512 + h * 128 + sc16 * 8); v1r = *(const u32x4*)(Pn + (size_t)(sv0 + 32) * NPROJ + 512 + h * 128 + sc16 * 8);
        }
        u32x2 ogr[4];
#pragma unroll
        for (int g4 = 0; g4 < 4; ++g4) ogr[g4] = *(const u32x2*)(Pb + (size_t)(64 * c + ((t & 63) < ntok ? t : 0)) * NPROJ + 1024 + h * 128 + 32 * vb + 8 * g4 + 4 * hi);
        const float gt = lg[64 * c + t], bt = lb[64 * c + t], mprev = lmp[c];
        f32x16 s0, s1, inter, nqa;
#pragma unroll
        for (int r = 0; r < 16; ++r) { s0[r] = 0.f; s1[r] = 0.f; inter[r] = 0.f; nqa[r] = 0.f; }
#pragma unroll
        for (int stp = 0; stp < 4; ++stp) {
            const int c8 = 2 * stp + hi;
            const bf16x8 qf = lds_frag(buf + ML_Q + rimg(t, c8, 64));
            const bf16x8 k0 = lds_frag(buf + ML_K + rimg(r32, c8, 64)), k1 = lds_frag(buf + ML_K + rimg(32 + r32, c8, 64));
            const bf16x8 cf = lds_frag(lds + ML_C + rimg(32 * vb + r32, c8, 128));
            s0 = __builtin_amdgcn_mfma_f32_32x32x16_bf16(k0, qf, s0, 0, 0, 0);
            s1 = __builtin_amdgcn_mfma_f32_32x32x16_bf16(k1, qf, s1, 0, 0, 0);
            inter = __builtin_amdgcn_mfma_f32_32x32x16_bf16(cf, qf, inter, 0, 0, 0);
            nqa = __builtin_amdgcn_mfma_f32_32x32x16_bf16(lds_frag(lds + ML_N + c8 * 16), qf, nqa, 0, 0, 0);
        }
        float dsum = 0.f;
#pragma unroll
        for (int r = 0; r < 16; ++r) {
            const int sA = crow(r, hi), sB = 32 + sA;
            const float wA = (sA <= t) ? __expf(la[64 * c + sA] - gt) : 0.f, wB = (sB <= t) ? __expf(la[64 * c + sB] - gt) : 0.f;
            s0[r] *= wA; s1[r] *= wB; dsum += s0[r] + s1[r];
        }
        dsum += __shfl_xor(dsum, 32);
        f32x16 intra;
#pragma unroll
        for (int r = 0; r < 16; ++r) intra[r] = 0.f;
        {
            const bf16x8 pf0 = pack8(s0, 0), pf1 = pack8(s0, 1), pf2 = pack8(s1, 0), pf3 = pack8(s1, 1);
            const ldsp vq = buf + ML_V + vlane + vb * 4096;
            intra = __builtin_amdgcn_mfma_f32_32x32x16_bf16(vtr2(vq), pf0, intra, 0, 0, 0);
            intra = __builtin_amdgcn_mfma_f32_32x32x16_bf16(vtr2(vq + 1024), pf1, intra, 0, 0, 0);
            intra = __builtin_amdgcn_mfma_f32_32x32x16_bf16(vtr2(vq + 2048), pf2, intra, 0, 0, 0);
            intra = __builtin_amdgcn_mfma_f32_32x32x16_bf16(vtr2(vq + 3072), pf3, intra, 0, 0, 0);
        }
        const float nq = nqa[0];
        const float winter = __expf(mprev - gt);
        float den = dsum + winter * nq;
        den = fmaxf(fabsf(den), __expf(-(bt + gt)));
        const float rden = 1.0f / den;
        float ssq = 0.f;
#pragma unroll
        for (int r = 0; r < 16; ++r) { const float hv = (intra[r] + winter * inter[r]) * rden; intra[r] = hv; ssq += hv * hv; }
        ssq += __shfl_xor(ssq, 32);
        if (hi == 0) lss[vb * 64 + t] = ssq;
        __syncthreads();
        {
            const float tot = lss[t] + lss[64 + t] + lss[128 + t] + lss[192 + t];
            const float rstd = __builtin_amdgcn_rsqf(tot * (1.0f / 128.0f) + EPS);
            if ((t & 63) < ntok) {
                const size_t rowo = (size_t)(64 * c + t);
                bf16_t* orow = Hb + rowo * D;
#pragma unroll
                for (int g4 = 0; g4 < 4; ++g4) { const int dd = 32 * vb + 8 * g4 + 4 * hi; const f32x4 gv = *(const f32x4*)(gm + dd); const u32x2 ov = ogr[g4];
                    u32x2 o; o.x = pk2(intra[4 * g4] * rstd * gv[0] * bflo(ov.x), intra[4 * g4 + 1] * rstd * gv[1] * bfhi(ov.x));
                    o.y = pk2(intra[4 * g4 + 2] * rstd * gv[2] * bflo(ov.y), intra[4 * g4 + 3] * rstd * gv[3] * bfhi(ov.y));
                    *(u32x2*)(orow + dd) = o; }
            }
        }
        {
            const float wstate = __expf(mprev - lg[64 * c + 63]);
#pragma unroll
            for (int r = 0; r < 16; ++r) Cacc[r] *= wstate;
            const ldsp vq = buf + ML_V + vlane + vb * 4096; const ldsp kq = buf + ML_KT + vlane + db * 4096;
            f32x16 nsum;
#pragma unroll
            for (int r = 0; r < 16; ++r) nsum[r] = 0.f;
            const bf16x8 ones = {0x3f80, 0x3f80, 0x3f80, 0x3f80, 0x3f80, 0x3f80, 0x3f80, 0x3f80};
#pragma unroll
            for (int ks = 0; ks < 4; ++ks) { const bf16x8 kf = vtr2(kq + ks * 1024); Cacc = __builtin_amdgcn_mfma_f32_32x32x16_bf16(vtr2(vq + ks * 1024), kf, Cacc, 0, 0, 0);
                nsum = __builtin_amdgcn_mfma_f32_32x32x16_bf16(ones, kf, nsum, 0, 0, 0); }
            nreg = nreg * wstate + nsum[0];
#pragma unroll
            for (int r = 0; r < 16; ++r) { const int dv = 32 * vb + crow(r, hi), dk = 32 * db + r32; *(LAS bf16_t*)(lds + ML_C + rimg(dv, dk >> 3, 128) + (dk & 7) * 2) = (bf16_t)f2bf(Cacc[r]); }
            if (vb == 0 && hi == 0) *(LAS bf16_t*)(lds + ML_N + (32 * db + r32) * 2) = (bf16_t)f2bf(nreg);
        }
    }
    __syncthreads();
#pragma unroll
    for (int r = 0; r < 16; ++r) { const int dv = 32 * vb + crow(r, hi), dk = 32 * db + r32; Cout[dv * 64 + dk] = Cacc[r]; }
    if (vb == 0 && hi == 0) nout[32 * db + r32] = nreg;
}

constexpr int U_ML = 128, U_AS = 32, U_AP = 2048, U_MS = 32, NUNITS = U_ML + U_AS + U_AP + U_MS;
__device__ __forceinline__ void mixer_phase(const Args& a, ldsp lds, int rep) {
    unsigned char* ws = a.ws;
    unsigned* ctr = (unsigned*)(ws + WS_CTL) + rep;
    const float lam = ((const float*)(ws + WS_CTL))[64];
    const bf16_t* P = (const bf16_t*)(ws + WS_P); bf16_t* H = (bf16_t*)(ws + WS_H);
    const float* gates = (const float*)(ws + WS_GATES);
    LAS unsigned* su = (LAS unsigned*)(lds + 131072);
    float* out = a.out;
    const int w = __builtin_amdgcn_readfirstlane(threadIdx.x >> 6);
    for (;;) {
        __syncthreads();
        if (threadIdx.x == 0) su[0] = atomicAdd(ctr, 1u);
        __syncthreads();
        int u = __builtin_amdgcn_readfirstlane((int)su[0]);
        if (u >= NUNITS) break;
        const bool is_ml = (u < U_ML) || (u >= U_ML + U_AS + U_AP);
        if (is_ml) {
            const bool samp = u >= U_ML; if (samp) u -= U_ML + U_AS + U_AP;
            const int b = u >> 2, h = u & 3;
            const size_t row0 = samp ? (size_t)(MP + 16 * b) : (size_t)b * SEQ;
            mlstm_unit(lds, P + row0 * NPROJ, gates + row0 * 8, h, samp ? 1 : 32, samp ? 16 : 64,
                       samp ? a.in[4] + (size_t)u * 8192 : nullptr, samp ? a.in[5] + u * 64 : nullptr, samp ? a.in[6] + u : nullptr,
                       H + row0 * D + h * 128, a.in[17] + h * 128,
                       out + (samp ? O_CS : O_CP) + (size_t)u * 8192, out + (samp ? O_NS : O_NP) + u * 64, out + (samp ? O_MS : O_MPR) + u);
        } else {
            u -= U_ML;
            const bool samp = u < U_AS; if (!samp) u -= U_AS;
            const int qb = samp ? 0 : 15 - (u >> 7), bh = samp ? u : (u & 127), b = bh >> 2, h = bh & 3;
            const size_t qrow0 = samp ? (size_t)(MP + 16 * b) : (size_t)b * SEQ + 128 * qb;
            const bf16_t* Kg = samp ? (const bf16_t*)(ws + WS_SK) + (size_t)b * 1088 * 512 + h * 128 : P + (size_t)b * SEQ * NPROJ + 2048 + h * 128;
            const bf16_t* Vg = samp ? (const bf16_t*)(ws + WS_SV) + (size_t)b * 1088 * 512 + h * 128 : P + (size_t)b * SEQ * NPROJ + 2560 + h * 128;
            const int lim = samp ? ((w >> 1) == 0 ? 16 : -1) : 2 * qb + (w >> 2);
            attn_unit(lds, P + qrow0 * NPROJ + 1536 + h * 128, NPROJ, samp ? 16 : 128, Kg, Vg, samp ? 512 : NPROJ, samp ? 17 : 2 * qb + 2, lim, samp ? 16 : 64,
                      H + qrow0 * D + 512 + h * 128, a.in[18] + h * 128, lam);
        }
    }
}

template <int MODE, int SB  , int NB  >
__device__ __forceinline__ void mini_gemm(ldsp lds, const bf16_t* A, const bf16_t* Bt, int K, int ntn, bf16_t* O, const Args& a) {
    int tid = threadIdx.x; asm volatile("" : "+v"(tid));
    const int lane = tid & 63, w = __builtin_amdgcn_readfirstlane(tid >> 6), r32 = lane & 31, hi = lane >> 5;
    LAS float* red = (LAS float*)lds;
    unsigned char* ws = a.ws;
    for (int task = blockIdx.x; task < 4 * ntn; task += gridDim.x) {
        const int mt = task / ntn, nt = task % ntn;
        const int wrow0 = (MODE == 1) ? (256 * (nt >> 2) + 32 * (nt & 3)) : 32 * nt;
        const bf16_t* ap = A + (size_t)(32 * mt + r32) * K + (size_t)w * (SB * NB * 16) + 8 * hi;
        const bf16_t* bp = Bt + (size_t)(wrow0 + r32) * K + (size_t)w * (SB * NB * 16) + 8 * hi;
        f32x16 acc0, acc1;
#pragma unroll
        for (int r = 0; r < 16; ++r) { acc0[r] = 0.f; acc1[r] = 0.f; }
#pragma unroll 1
        for (int nb = 0; nb < NB; ++nb) {
            bf16x8 af[SB], b0[SB], b1[SB];
#pragma unroll
            for (int i = 0; i < SB; ++i) { af[i] = *(const bf16x8*)(ap + (nb * SB + i) * 16); b0[i] = *(const bf16x8*)(bp + (nb * SB + i) * 16);
                if (MODE == 1) b1[i] = *(const bf16x8*)(bp + (size_t)128 * K + (nb * SB + i) * 16); }
#pragma unroll
            for (int i = 0; i < SB; ++i) { acc0 = __builtin_amdgcn_mfma_f32_32x32x16_bf16(b0[i], af[i], acc0, 0, 0, 0);
                if (MODE == 1) acc1 = __builtin_amdgcn_mfma_f32_32x32x16_bf16(b1[i], af[i], acc1, 0, 0, 0); }
        }
#pragma unroll
        for (int r = 0; r < 16; ++r) { red[((w * 2 + 0) * 16 + r) * 64 + lane] = acc0[r]; if (MODE == 1) red[((w * 2 + 1) * 16 + r) * 64 + lane] = acc1[r]; }
        __syncthreads();
        {
            LAS float* fin = (LAS float*)(lds + 65536);
#pragma unroll
            for (int rr = 0; rr < 2; ++rr) { const int r = 2 * w + rr; float s0 = 0.f, s1 = 0.f;
#pragma unroll
                for (int k = 0; k < 8; ++k) { s0 += red[((k * 2 + 0) * 16 + r) * 64 + lane]; if (MODE == 1) s1 += red[((k * 2 + 1) * 16 + r) * 64 + lane]; }
                fin[r * 64 + lane] = s0; if (MODE == 1) fin[(16 + r) * 64 + lane] = s1; }
        }
        __syncthreads();
        if (w == 0) {
            const LAS float* fin = (const LAS float*)(lds + 65536);
#pragma unroll
            for (int r = 0; r < 16; ++r) { acc0[r] = fin[r * 64 + lane]; acc1[r] = (MODE == 1) ? fin[(16 + r) * 64 + lane] : 0.f; }
            const int srow = 32 * mt + r32;
            if (MODE == 0) {
                bf16_t* o = O + (size_t)srow * D + 32 * nt;
#pragma unroll
                for (int g = 0; g < 4; ++g) { u32x2 v; v.x = pk2(acc0[4 * g], acc0[4 * g + 1]); v.y = pk2(acc0[4 * g + 2], acc0[4 * g + 3]); *(u32x2*)(o + 8 * g + 4 * hi) = v; }
            } else if (MODE == 1) {
                bf16_t* o = O + (size_t)srow * FF + 32 * nt;
#pragma unroll
                for (int r = 0; r < 16; ++r) acc0[r] = acc0[r] * pg8::fast_sigmoid(acc0[r]) * acc1[r];
#pragma unroll
                for (int g = 0; g < 4; ++g) { u32x2 v; v.x = pk2(acc0[4 * g], acc0[4 * g + 1]); v.y = pk2(acc0[4 * g + 2], acc0[4 * g + 3]); *(u32x2*)(o + 8 * g + 4 * hi) = v; }
            } else {
                const int col0 = 32 * nt, pn = col0 >> 8;
                const int type = (pn == 0) ? 0 : (pn == 1) ? 1 : (pn < 4) ? 2 : (pn < 6) ? 3 : (pn < 8) ? 4 : (pn < 10) ? 5 : 6;
                if (type == 1) {
#pragma unroll
                    for (int r = 0; r < 16; ++r) acc0[r] *= 0.125f;
                } else if (type == 3) {
#pragma unroll
                    for (int r = 0; r < 16; ++r) acc0[r] = pg8::fast_sigmoid(acc0[r]);
                } else if ((type == 4 || type == 5) && (col0 & 63) == 0) {
                    const float* t = (const float*)(ws + WS_ROPE) + (1024 + (srow & 15)) * 16 + 4 * hi;
                    const f32x4 cs = *(const f32x4*)t, sn = *(const f32x4*)(t + 8);
#pragma unroll
                    for (int j = 0; j < 4; ++j) { const float x1 = acc0[j], x2 = acc0[4 + j]; acc0[j] = x1 * cs[j] - x2 * sn[j]; acc0[4 + j] = x2 * cs[j] + x1 * sn[j]; }
                }
                if (type >= 5) {
                    const int c512 = col0 - (type == 5 ? 2048 : 2560);
                    float* o = a.out + (type == 5 ? O_KS : O_VS) + (size_t)srow * 512 + c512;
#pragma unroll
                    for (int g = 0; g < 4; ++g) *(f32x4*)(o + 8 * g + 4 * hi) = (f32x4){acc0[4 * g], acc0[4 * g + 1], acc0[4 * g + 2], acc0[4 * g + 3]};
                }
                if (type == 4) {
#pragma unroll
                    for (int r = 0; r < 16; ++r) acc0[r] *= (0.125f * 1.4426950408889634f);
                }
                bf16_t* o = O + (size_t)srow * NPROJ + col0;
                bf16_t* o2 = (bf16_t*)(ws + (type == 5 ? WS_SK : WS_SV)) + ((size_t)((srow >> 4) * 1088 + 1024 + (srow & 15)) * 512 + (col0 - (type == 5 ? 2048 : 2560)));
#pragma unroll
                for (int g = 0; g < 4; ++g) { u32x2 v; v.x = pk2(acc0[4 * g], acc0[4 * g + 1]); v.y = pk2(acc0[4 * g + 2], acc0[4 * g + 3]); *(u32x2*)(o + 8 * g + 4 * hi) = v;
                    if (type >= 5) *(u32x2*)(o2 + 8 * g + 4 * hi) = v; }
            }
        }
        __syncthreads();
    }
}

#define XB_TMO      128
#define XB_XCNT(j)  (256  + 64 * (j))
#define XB_XSUB(j)  (1280 + 64 * (j))
#define XB_XGEN(j)  (2304 + 64 * (j))
#define XB_TOP      3328
#define XB_TOPGEN   3392
#define XCD_BAR_WORDS 3456
#define XB_SPIN_CAP (1u << 22)

__device__ __forceinline__ unsigned xb_ld(unsigned* p)              { return __hip_atomic_load(p, __ATOMIC_RELAXED, __HIP_MEMORY_SCOPE_AGENT); }
__device__ __forceinline__ unsigned xb_add(unsigned* p, unsigned v) { return __hip_atomic_fetch_add(p, v, __ATOMIC_RELAXED, __HIP_MEMORY_SCOPE_AGENT); }
__device__ __forceinline__ unsigned xb_xcc_id() { return (unsigned)__builtin_amdgcn_s_getreg((3 << 11) | 20) & 0xFu; }
#define XB_SPIN(cond, bar) do { unsigned _sp = 0; while (cond) { __builtin_amdgcn_s_sleep(1); \
    if ((++_sp & 255u) == 0u) { if (xb_ld(&(bar)[XB_TMO])) break; if (_sp > XB_SPIN_CAP) { atomicAdd(&(bar)[XB_TMO], 1u); break; } } } } while (0)

struct XcdBarrier {
    unsigned* bar; unsigned x;
    volatile LAS unsigned* st;
};

__device__ __forceinline__ XcdBarrier xcd_barrier_post(unsigned* bar, volatile LAS unsigned* st) {
    XcdBarrier b; b.bar = bar; b.x = xb_xcc_id(); b.st = st;
    if (threadIdx.x == 0) (void)xb_add(&bar[XB_XCNT(b.x)], 1u);
    return b;
}
__device__ __forceinline__ void xcd_barrier_complete(unsigned* bar, unsigned x, unsigned& nloc, unsigned& nx) {
    const unsigned G = gridDim.x * gridDim.y * gridDim.z;
    unsigned sum, cnt, mine, sp = 0u;
    for (;;) {
        sum = 0u; cnt = 0u; mine = 0u;
#pragma unroll
        for (unsigned j = 0; j < 16; ++j) { const unsigned c = xb_ld(&bar[XB_XCNT(j)]); sum += c; cnt += (c > 0u) ? 1u : 0u; mine = (j == x) ? c : mine; }
        if (sum == G) break;
        __builtin_amdgcn_s_sleep(1);
        if ((++sp & 255u) == 0u) { if (xb_ld(&bar[XB_TMO])) break; if (sp > XB_SPIN_CAP) { atomicAdd(&bar[XB_TMO], 1u); break; } }
    }
    nloc = mine > 0u ? mine : 1u; nx = cnt > 0u ? cnt : 1u;
}

__device__ __forceinline__ void xcd_barrier(const XcdBarrier& b) {
    asm volatile("s_waitcnt vmcnt(0)" ::: "memory");
    __syncthreads();
    if (threadIdx.x == 0) {
        unsigned* bar = b.bar;
        __builtin_amdgcn_s_waitcnt(0);
        unsigned nloc = b.st[0], nx = b.st[1];
        if (nloc == 0u) { xcd_barrier_complete(bar, b.x, nloc, nx); b.st[0] = nloc; b.st[1] = nx; }
        const unsigned old = xb_add(&bar[XB_XSUB(b.x)], 1u);
        const unsigned gen = old / nloc;
        if (old + 1u == (gen + 1u) * nloc) {
            __builtin_amdgcn_fence(__ATOMIC_RELEASE, "agent");
            asm volatile("s_waitcnt vmcnt(0)" ::: "memory");
            const unsigned og = xb_add(&bar[XB_TOP], 1u);
            const unsigned tg = og / nx;
            if (og + 1u == (tg + 1u) * nx) xb_add(&bar[XB_TOPGEN], 1u);
            else XB_SPIN(xb_ld(&bar[XB_TOPGEN]) == tg, bar);
            __builtin_amdgcn_fence(__ATOMIC_ACQUIRE, "agent");
            xb_add(&bar[XB_XGEN(b.x)], 1u);
            asm volatile("s_waitcnt vmcnt(0)" ::: "memory");
        } else {
            XB_SPIN(xb_ld(&bar[XB_XGEN(b.x)]) == gen, bar);
            __builtin_amdgcn_fence(__ATOMIC_ACQUIRE, "agent");
            asm volatile("s_waitcnt vmcnt(0)" ::: "memory");
        }
    }
    __syncthreads();
}

constexpr int NPHASE = 12;
#ifndef REP_MASK
#define REP_MASK 0
#endif
template <bool COOP>
__global__ void __launch_bounds__(NTHR, 2) mega(Args a) {
    extern __shared__ __attribute__((aligned(16))) unsigned char lds_raw[];
    ldsp lds = (ldsp)lds_raw;
    unsigned char* ws = a.ws;
    const int lo = a.ph_lo, hi = a.ph_hi, G = gridDim.x, bx = blockIdx.x;
#define IN(k) (lo <= (k) && (k) < hi)
    XcdBarrier bar; bar.bar = (unsigned*)(ws + WS_CTL) + 4096; bar.x = 0; bar.st = nullptr;
    if (COOP) {
        volatile LAS unsigned* misc = (volatile LAS unsigned*)(lds + 131072 + 64);
        if (threadIdx.x < 2) misc[threadIdx.x] = 0u;
        __syncthreads();
        bar = xcd_barrier_post((unsigned*)(ws + WS_CTL) + 4096, misc);
    }
#define SEAM(k) do { if (COOP) { if (IN(k) && IN((k) + 1)) { if ((k) == 0) cg::this_grid().sync(); else xcd_barrier(bar); } } } while (0)
    bf16_t* H = (bf16_t*)(ws + WS_H); bf16_t* F = (bf16_t*)(ws + WS_F); bf16_t* P = (bf16_t*)(ws + WS_P);
    float* X = a.out + O_Y;
    if (IN(0)) { for (int rep = 0; rep < 1 + ((REP_MASK >> 0) & 1); ++rep) { if (rep) { if (COOP) xcd_barrier(bar); } p0_prologue(a, lds); } } SEAM(0);
    if (IN(1)) { for (int rep = 0; rep < 1 + ((REP_MASK >> 1) & 1); ++rep) { if (rep) { if (COOP) xcd_barrier(bar); } row_phase<false, true, false>(a, lds, a.in[0], a.in[1], nullptr, 0, 0.f, 0, 0, 0, 1); } } SEAM(1);
    if (IN(2)) { for (int rep = 0; rep < 1 + ((REP_MASK >> 2) & 1); ++rep) { if (rep) { if (COOP) xcd_barrier(bar); } pg8::Gemm g{H, (const bf16_t*)(ws + WS_W1I), MP, 2 * FF, D}; pg8::StaticOrder S; S.init(MP, 2 * FF, G, bx); pg8::EpiSwiglu E{P, FF, 1.0f};
        pg8::gemm_phase<pg8::EpiSwiglu, pg8::StaticOrder, true, true>(lds, g, S, E);
        mini_gemm<1, 8, 1>(lds, H + (size_t)MP * D, (const bf16_t*)(ws + WS_W1I), D, FF / 32, P + (size_t)MP * FF, a); } } SEAM(2);
    if (IN(3)) { for (int rep = 0; rep < 1 + ((REP_MASK >> 3) & 1); ++rep) { if (rep) { if (COOP) xcd_barrier(bar); } pg8::Gemm g{P, (const bf16_t*)(ws + WS_W1O), MP, D, FF}; pg8::StaticOrder S; S.init(MP, D, G, bx); pg8::EpiPlain E{F, D, 1.0f};
        pg8::gemm_phase<pg8::EpiPlain, pg8::StaticOrder, true, true>(lds, g, S, E);
        mini_gemm<0, 11, 2>(lds, P + (size_t)MP * FF, (const bf16_t*)(ws + WS_W1O), FF, D / 32, F + (size_t)MP * D, a); } } SEAM(3);
    if (IN(4)) { for (int rep = 0; rep < 1 + ((REP_MASK >> 4) & 1); ++rep) { if (rep) { if (COOP) xcd_barrier(bar); } row_phase<true, true, true, false, false, true>(a, lds, a.in[0], a.in[1], X, 2, 0.5f, 1, 2, 3, 4); } } SEAM(4);
    if (IN(5)) { for (int rep = 0; rep < 1 + ((REP_MASK >> 5) & 1); ++rep) { if (rep) { if (COOP) xcd_barrier(bar); } pg8::Gemm g{H, (const bf16_t*)(ws + WS_WIN), MP, NPROJ, D}; pg8::StaticOrder S; S.init(MP, NPROJ, G, bx);
        pg8::EpiProj E{P, (bf16_t*)(ws + WS_SK), (bf16_t*)(ws + WS_SV), a.out + O_KP, a.out + O_VP, a.out + O_KS, a.out + O_VS, (const float*)(ws + WS_ROPE)};
        pg8::gemm_phase<pg8::EpiProj, pg8::StaticOrder, true, true>(lds, g, S, E);
        mini_gemm<2, 8, 1>(lds, H + (size_t)MP * D, (const bf16_t*)(ws + WS_WIN), D, NPROJ / 32, P + (size_t)MP * NPROJ, a); } } SEAM(5);
    if (IN(6)) { for (int rep = 0; rep < 1 + ((REP_MASK >> 6) & 1); ++rep) { if (rep) { if (COOP) xcd_barrier(bar); } mixer_phase(a, lds, rep); } } SEAM(6);
    if (IN(7)) { for (int rep = 0; rep < 1 + ((REP_MASK >> 7) & 1); ++rep) { if (rep) { if (COOP) xcd_barrier(bar); } pg8::Gemm g{H, (const bf16_t*)(ws + WS_WO), MP, D, D}; pg8::StaticOrder S; S.init(MP, D, G, bx); pg8::EpiPlain E{F, D, 1.0f};
        pg8::gemm_phase<pg8::EpiPlain, pg8::StaticOrder, true, true>(lds, g, S, E);
        mini_gemm<0, 8, 1>(lds, H + (size_t)MP * D, (const bf16_t*)(ws + WS_WO), D, D / 32, F + (size_t)MP * D, a); } } SEAM(7);
    if (IN(8)) { for (int rep = 0; rep < 1 + ((REP_MASK >> 8) & 1); ++rep) { if (rep) { if (COOP) xcd_barrier(bar); } row_phase<true, true, false, true, true, true>(a, lds, X, X + (size_t)MP * D, X, 5, 1.0f, 3, 4, 6, 7); } } SEAM(8);
    if (IN(9)) { for (int rep = 0; rep < 1 + ((REP_MASK >> 9) & 1); ++rep) { if (rep) { if (COOP) xcd_barrier(bar); } pg8::Gemm g{H, (const bf16_t*)(ws + WS_W2I8), MP, 2 * FF, D / 2}; pg8::StaticOrder S; S.init(MP, 2 * FF, G, bx); pg8::EpiSwigluF8 E{(unsigned char*)P, FF, 1.0f / (H8_SCALE * W8_SCALE), A8_SCALE};
        pg8::gemm_phase<pg8::EpiSwigluF8, pg8::StaticOrder, true, true, true>(lds, g, S, E);
        mini_gemm<1, 8, 1>(lds, H + (size_t)MP * D, (const bf16_t*)(ws + WS_W2I), D, FF / 32, P + (size_t)MP * FF, a); } } SEAM(9);
    if (IN(10)) { for (int rep = 0; rep < 1 + ((REP_MASK >> 10) & 1); ++rep) { if (rep) { if (COOP) xcd_barrier(bar); } pg8::Gemm g{P, (const bf16_t*)(ws + WS_W2O8), MP, D, FF / 2}; pg8::StaticOrder S; S.init(MP, D, G, bx); pg8::EpiPlain E{F, D, 1.0f / (A8_SCALE * W8_SCALE)};
        pg8::gemm_phase<pg8::EpiPlain, pg8::StaticOrder, true, true, true>(lds, g, S, E);
        mini_gemm<0, 11, 2>(lds, P + (size_t)MP * FF, (const bf16_t*)(ws + WS_W2O), FF, D / 32, F + (size_t)MP * D, a); } } SEAM(10);
    if (IN(11)) { for (int rep = 0; rep < 1 + ((REP_MASK >> 11) & 1); ++rep) { if (rep) { if (COOP) xcd_barrier(bar); } row_phase<true, false, false, false, true, false>(a, lds, X, X + (size_t)MP * D, X, 8, 0.5f, 5, 0, 0, 0); } }
#undef IN
#undef SEAM
}

#ifndef MK_LAUNCHES
#define MK_LAUNCHES 1
#endif
extern "C" void kernel_launch(void* const* d_in, const int* in_sizes, int n_in, void* d_out, int out_size, void* d_ws, size_t ws_size, hipStream_t stream) {
    static int grid = 0;
    if (grid == 0) {
        if (n_in != 23 || (size_t)out_size != O_END || ws_size < WS_END) { fprintf(stderr, "kernel_launch: unexpected shapes (n_in %d, out %d, ws %zu)\n", n_in, out_size, ws_size); grid = -1; return; }
        int dev = 0, cus = 0, per_cu = 0;
        hipGetDevice(&dev); hipDeviceGetAttribute(&cus, hipDeviceAttributeMultiprocessorCount, dev);
        hipFuncSetAttribute((const void*)mega<true>, hipFuncAttributeMaxDynamicSharedMemorySize, LDS_BYTES);
        hipFuncSetAttribute((const void*)mega<false>, hipFuncAttributeMaxDynamicSharedMemorySize, LDS_BYTES);
        hipOccupancyMaxActiveBlocksPerMultiprocessor(&per_cu, (const void*)mega<true>, NTHR, LDS_BYTES);
        if (per_cu < 1) per_cu = 1;
        (void)hipGetLastError();
        grid = cus * per_cu;
    }
    if (grid < 0) return;
    if (hipMemsetAsync(d_ws, 0, 65536, stream) != hipSuccess) { fprintf(stderr, "kernel_launch: memset failed\n"); return; }
    Args a{};
    for (int i = 0; i < 23; ++i) a.in[i] = (const float*)d_in[i];
    a.out = (float*)d_out; a.ws = (unsigned char*)d_ws;
    if (MK_LAUNCHES == 1) {
        a.ph_lo = 0; a.ph_hi = NPHASE;
        void* args[] = {&a};
        hipError_t e = hipLaunchCooperativeKernel((const void*)mega<true>, dim3(grid), dim3(NTHR), args, LDS_BYTES, stream);
        if (e != hipSuccess) fprintf(stderr, "cooperative launch failed: %s (grid %d)\n", hipGetErrorString(e), grid);
    } else {
        for (int p = 0; p < NPHASE; ++p) { a.ph_lo = p; a.ph_hi = p + 1; hipLaunchKernelGGL(mega<false>, dim3(grid), dim3(NTHR), LDS_BYTES, stream, a); }
    }
}
```

```cpp
#include <hip/hip_runtime.h>
#include <hip/hip_cooperative_groups.h>
#include <cstdio>
#include <cstdint>
#include <cmath>
namespace pg8 {
#define PG8_LAS __attribute__((address_space(3)))
typedef unsigned short bf16_t;
typedef short bf16x8 __attribute__((ext_vector_type(8)));
typedef float f32x4 __attribute__((ext_vector_type(4)));
typedef unsigned u32x4 __attribute__((ext_vector_type(4)));
typedef int v8i32 __attribute__((ext_vector_type(8)));
typedef int v4i32 __attribute__((ext_vector_type(4)));
constexpr int BM = 256, BK = 64, HALF = 128, HTB = HALF * BK * 2  , STAGE_BYTES = 8 * HTB, NXCD = 8, WGM = 8;

__host__ __device__ __forceinline__ int lds_byte(int r, int c) { const int st = (r >> 4) * 2 + (c >> 5), rr = r & 15, cc = c & 31, ob = rr * 64 + cc * 2; return st * 1024 + (ob ^ (((ob >> 9) & 1) << 5)); }
__host__ __device__ __forceinline__ void stage_rc(int b, int& R, int& C) { const int st = b / 1024, sb = b % 1024, swz = sb ^ (((sb >> 9) & 1) << 5); R = (st >> 1) * 16 + swz / 64; C = (st & 1) * 32 + (swz % 64) / 2; }
__host__ __device__ __forceinline__ int perm32(int rho) { const int n = rho >> 4, i = rho & 15; return 8 * (i >> 2) + 4 * n + (i & 3); }

struct Unit { int pm, pn; };
struct Gemm { const bf16_t* A; const bf16_t* Bt; int M, N, K; };

struct StaticOrder {
    int nM, nN, nwg, G, c;
    __host__ __device__ void init(int M, int N, int G_, int c_) { nM = M / BM; nN = N / BM; nwg = nM * nN; G = G_; c = c_; }
    __host__ __device__ bool next(int i, Unit& u) const {
        const long L = (long)i * G + c; if (L >= nwg) return false;
        int wgid = (int)L; { const int q = nwg / NXCD, r = nwg % NXCD, xcd = wgid % NXCD, off = wgid / NXCD; wgid = (xcd < r ? xcd * (q + 1) : r * (q + 1) + (xcd - r) * q) + off; }
        const int nig = WGM * nN, gid = wgid / nig, fm = gid * WGM, gsz = (nM - fm) < WGM ? (nM - fm) : WGM;
        u.pm = fm + ((wgid % nig) % gsz); u.pn = (wgid % nig) / gsz; return true;
    }
    __device__ __forceinline__ void a_ready(const Unit&) const {}
    __device__ __forceinline__ void done(const Unit&) const {}
};
__device__ __forceinline__ unsigned cvt_pk_bf16(float lo, float hi) { unsigned r; asm volatile("v_cvt_pk_bf16_f32 %0, %1, %2" : "=v"(r) : "v"(lo), "v"(hi)); return r; }
typedef float f32x2 __attribute__((ext_vector_type(2)));
typedef unsigned u32x4 __attribute__((ext_vector_type(4)));
constexpr int E_MP = 65536, E_MV = 65664;
__device__ __forceinline__ float fast_sigmoid(float x) { return __builtin_amdgcn_rcpf(1.0f + __expf(-x)); }
struct EpiSwiglu {
    static constexpr bool PERM = true, AFTER_DRAIN = false;
    bf16_t* O; int ldo; float sc;
    __device__ __forceinline__ void operator()(const f32x4 (&acc)[2][2][4][2], const Unit& u, int wr, int wc, int fr, int fq) const {
        const int row0 = u.pm * BM + wr * 64 + fr, col0 = u.pn * 128 + wc * 32 + 8 * fq;
#pragma unroll
        for (int ai = 0; ai < 2; ++ai)
#pragma unroll
            for (int m = 0; m < 4; ++m) {
                bf16_t* p = O + (size_t)(row0 + ai * HALF + m * 16) * ldo + col0;
                const f32x4 g0 = acc[ai][0][m][0] * sc, g1 = acc[ai][0][m][1] * sc, u0 = acc[ai][1][m][0] * sc, u1 = acc[ai][1][m][1] * sc;
                f32x4 a0, a1;
#pragma unroll
                for (int j = 0; j < 4; ++j) { a0[j] = g0[j] * fast_sigmoid(g0[j]) * u0[j]; a1[j] = g1[j] * fast_sigmoid(g1[j]) * u1[j]; }
                u32x4 w; w.x = cvt_pk_bf16(a0[0], a0[1]); w.y = cvt_pk_bf16(a0[2], a0[3]); w.z = cvt_pk_bf16(a1[0], a1[1]); w.w = cvt_pk_bf16(a1[2], a1[3]);
                *(u32x4*)p = w;
            }
    }
};
struct EpiSwiglu8 {
    static constexpr bool PERM = false, AFTER_DRAIN = false;
    bf16_t* O; int ldo; float sc;
    __device__ __forceinline__ void operator()(const f32x4 (&acc)[2][2][4][2], const Unit& u, int wr, int wc, int fr, int fq) const {
        typedef unsigned u32x2e __attribute__((ext_vector_type(2)));
        const int row0 = u.pm * BM + wr * 64 + fr, col0 = u.pn * 128 + wc * 32 + 4 * fq;
#pragma unroll
        for (int ai = 0; ai < 2; ++ai)
#pragma unroll
            for (int m = 0; m < 4; ++m) {
                bf16_t* p = O + (size_t)(row0 + ai * HALF + m * 16) * ldo + col0;
#pragma unroll
                for (int n = 0; n < 2; ++n) {
                    const f32x4 g = acc[ai][0][m][n] * sc, up = acc[ai][1][m][n] * sc;
                    f32x4 a0;
#pragma unroll
                    for (int j = 0; j < 4; ++j) a0[j] = g[j] * fast_sigmoid(g[j]) * up[j];
                    u32x2e w; w.x = cvt_pk_bf16(a0[0], a0[1]); w.y = cvt_pk_bf16(a0[2], a0[3]);
                    *(u32x2e*)(p + 16 * n) = w;
                }
            }
    }
};
struct EpiSwigluF8 {
    static constexpr bool PERM = false, AFTER_DRAIN = false;
    unsigned char* O; int ldo; float sc, so;
    __device__ __forceinline__ void operator()(const f32x4 (&acc)[2][2][4][2], const Unit& u, int wr, int wc, int fr, int fq) const {
        const int row0 = u.pm * BM + wr * 64 + fr, col0 = u.pn * 128 + wc * 32 + 4 * fq;
#pragma unroll
        for (int ai = 0; ai < 2; ++ai)
#pragma unroll
            for (int m = 0; m < 4; ++m) {
                unsigned char* p = O + (size_t)(row0 + ai * HALF + m * 16) * ldo + col0;
#pragma unroll
                for (int n = 0; n < 2; ++n) {
                    const f32x4 g = acc[ai][0][m][n] * sc, up = acc[ai][1][m][n] * sc;
                    f32x4 a0;
#pragma unroll
                    for (int j = 0; j < 4; ++j) a0[j] = g[j] * fast_sigmoid(g[j]) * up[j] * so;
                    unsigned q = 0u;
                    q = __builtin_amdgcn_cvt_pk_fp8_f32(a0[0], a0[1], q, false); q = __builtin_amdgcn_cvt_pk_fp8_f32(a0[2], a0[3], q, true);
                    *(unsigned*)(p + 16 * n) = q;
                }
            }
    }
};
struct EpiPlain {
    static constexpr bool PERM = true, AFTER_DRAIN = false;
    bf16_t* O; int ldo; float sc;
    __device__ __forceinline__ void operator()(const f32x4 (&acc)[2][2][4][2], const Unit& u, int wr, int wc, int fr, int fq) const {
        const int row0 = u.pm * BM + wr * 64 + fr, col0 = u.pn * BM + wc * 32 + 8 * fq;
#pragma unroll
        for (int ai = 0; ai < 2; ++ai)
#pragma unroll
            for (int m = 0; m < 4; ++m) {
                bf16_t* p = O + (size_t)(row0 + ai * HALF + m * 16) * ldo + col0;
#pragma unroll
                for (int bj = 0; bj < 2; ++bj) {
                    const f32x4 v0 = acc[ai][bj][m][0] * sc, v1 = acc[ai][bj][m][1] * sc;
                    u32x4 w; w.x = cvt_pk_bf16(v0[0], v0[1]); w.y = cvt_pk_bf16(v0[2], v0[3]); w.z = cvt_pk_bf16(v1[0], v1[1]); w.w = cvt_pk_bf16(v1[2], v1[3]);
                    *(u32x4*)(p + bj * HALF) = w;
                }
            }
    }
};
struct EpiProj {
    static constexpr bool PERM = true, AFTER_DRAIN = false;
    bf16_t* P; bf16_t* SK; bf16_t* SV; float* okp; float* ovp; float* oks; float* ovs; const float* rope;
    __device__ __forceinline__ void operator()(const f32x4 (&acc)[2][2][4][2], const Unit& u, int wr, int wc, int fr, int fq) const {
        const int pn = u.pn;
        const int type = (pn == 0) ? 0 : (pn == 1) ? 1 : (pn < 4) ? 2 : (pn < 6) ? 3 : (pn < 8) ? 4 : (pn < 10) ? 5 : 6;
        const bool rot = (type == 4 || type == 5) && ((wc & 1) == 0);
        f32x4 ncs0 = {1.f, 1.f, 1.f, 1.f}, ncs1 = ncs0, nsn0 = {0.f, 0.f, 0.f, 0.f}, nsn1 = nsn0;
        if (rot) { const float* t = rope + ((u.pm * BM + wr * 64 + fr) & 2047) * 16; ncs0 = *(const f32x4*)t; ncs1 = *(const f32x4*)(t + 4); nsn0 = *(const f32x4*)(t + 8); nsn1 = *(const f32x4*)(t + 12); }
#pragma unroll
        for (int ai = 0; ai < 2; ++ai)
#pragma unroll
            for (int m = 0; m < 4; ++m) {
                const int row = u.pm * BM + ai * HALF + wr * 64 + m * 16 + fr;
                const bool samp = row >= E_MP, valid = row < E_MV;
                const f32x4 cs0 = ncs0, cs1 = ncs1, sn0 = nsn0, sn1 = nsn1;
                if (rot && (ai * 4 + m) < 7) { const int it = ai * 4 + m + 1; const float* t = rope + ((u.pm * BM + (it >> 2) * HALF + wr * 64 + (it & 3) * 16 + fr) & 2047) * 16;
                    ncs0 = *(const f32x4*)t; ncs1 = *(const f32x4*)(t + 4); nsn0 = *(const f32x4*)(t + 8); nsn1 = *(const f32x4*)(t + 12); }
#pragma unroll
                for (int bj = 0; bj < 2; ++bj) {
                    f32x4 v0 = acc[ai][bj][m][0], v1 = acc[ai][bj][m][1];
                    if (type == 1) { v0 = v0 * 0.125f; v1 = v1 * 0.125f; }
                    else if (type == 3) {
#pragma unroll
                        for (int j = 0; j < 4; ++j) { v0[j] = fast_sigmoid(v0[j]); v1[j] = fast_sigmoid(v1[j]); }
                    } else if (rot) {
                        f32x4 p0, p1;
#pragma unroll
                        for (int j = 0; j < 4; ++j) { p0[j] = __shfl_xor(v0[j], 16); p1[j] = __shfl_xor(v1[j], 16); }
                        if (fq == 0) { v0 = v0 * cs0 - p0 * sn0; v1 = v1 * cs1 - p1 * sn1; }
                        else if (fq == 1) { v0 = v0 * cs0 + p0 * sn0; v1 = v1 * cs1 + p1 * sn1; }
                    }
                    const int c512 = (pn & 1) * 256 + bj * HALF + wc * 32 + 8 * fq;
                    if (type >= 5 && valid) {
                        float* o = samp ? ((type == 5 ? oks : ovs) + (size_t)(row - E_MP) * 512 + c512) : ((type == 5 ? okp : ovp) + (size_t)row * 512 + c512);
                        *(f32x4*)o = v0; *(f32x4*)(o + 4) = v1;
                    }
                    if (type == 4) { v0 = v0 * (0.125f * 1.4426950408889634f); v1 = v1 * (0.125f * 1.4426950408889634f); }
                    u32x4 w; w.x = cvt_pk_bf16(v0[0], v0[1]); w.y = cvt_pk_bf16(v0[2], v0[3]); w.z = cvt_pk_bf16(v1[0], v1[1]); w.w = cvt_pk_bf16(v1[2], v1[3]);
                    *(u32x4*)(P + (size_t)row * 3072 + pn * BM + bj * HALF + wc * 32 + 8 * fq) = w;
                    if (type >= 5 && samp && valid) {
                        const int s = row - E_MP;
                        bf16_t* d = (type == 5 ? SK : SV) + ((size_t)((s >> 4) * 1088 + 1024 + (s & 15)) * 512 + c512);
                        *(u32x4*)d = w;
                    }
                }
            }
    }
};
template <class Epi, class Sched, bool ALIGN_EPI = false, bool SP2 = false, bool F8 = false  >
__device__ __forceinline__ void gemm_phase(PG8_LAS unsigned char* lds, const Gemm g, const Sched& S, const Epi& E) {
    int tid = threadIdx.x; asm volatile("" : "+v"(tid));
    const int wid = __builtin_amdgcn_readfirstlane(tid >> 6), lane = tid & 63, wr = wid >> 2, wc = wid & 3, fr = lane & 15, fq = lane >> 4;
    const int K = g.K, nt = K / BK;
    unsigned voffA[2], voffB[2];
    { int R, C; stage_rc(tid * 16, R, C); const int Rb = Epi::PERM ? ((R & ~31) + perm32(R & 31)) : R;
        voffA[0] = (unsigned)(R * K + C) * 2u; voffB[0] = (unsigned)(Rb * K + C) * 2u; voffA[1] = voffA[0] + (unsigned)(64 * K) * 2u; voffB[1] = voffB[0] + (unsigned)(64 * K) * 2u; }
    const size_t kstep = (size_t)(BK * 2);
    const size_t hstep = (size_t)HALF * K * 2;
    const size_t tstep = 2 * hstep;
    const unsigned ldsbase = (unsigned)(uintptr_t)lds; const size_t r64step = (size_t)(64 * K) * 2u;
    const unsigned ldsw = (unsigned)wid * 1024u;
    const int aoff = lds_byte(wr * 64 + fr, fq * 8), boff = lds_byte(wc * 32 + fr, fq * 8);
#define PG8_SA(b, h) (((b) * 2 + (h)) * HTB)
#define PG8_SB(b, h) ((4 + (b) * 2 + (h)) * HTB)
#define PG8_GLDS(vo, gp, ld) do { unsigned _keep; asm volatile("s_mov_b32 %0, m0\n\ts_mov_b32 m0, %3\n\ts_nop 0\n\tglobal_load_lds_dwordx4 %1, %2\n\ts_mov_b32 m0, %0" : "=&s"(_keep) : "v"(vo), "s"(gp), "s"(ld) : "memory"); } while (0)
#define PG8_STAGE(bufoff, gbase, voff) do { const char* _g = (const char*)(gbase); const unsigned _l = ldsbase + (unsigned)(bufoff) + ldsw; \
        PG8_GLDS((voff)[0], _g, _l); PG8_GLDS((voff)[0], _g + r64step, _l + 8192u); } while (0)
#define PG8_LDA(dst, b, h) do { _Pragma("unroll") for (int m = 0; m < 4; ++m) _Pragma("unroll") for (int k = 0; k < 2; ++k) dst[m][k] = *(const PG8_LAS v4i32*)(lds + PG8_SA(b, h) + aoff + m * 2048 + k * 1024); } while (0)
#define PG8_LDB(dst, b, h) do { _Pragma("unroll") for (int n = 0; n < 2; ++n) _Pragma("unroll") for (int k = 0; k < 2; ++k) dst[n][k] = *(const PG8_LAS v4i32*)(lds + PG8_SB(b, h) + boff + n * 2048 + k * 1024); } while (0)
#define PG8_CAT(x0, x1) __builtin_shufflevector(x0, x1, 0, 1, 2, 3, 4, 5, 6, 7)
#define PG8_MMA(ai, bj, At, Bt) do { __builtin_amdgcn_s_setprio(1); _Pragma("unroll") for (int m = 0; m < 4; ++m) _Pragma("unroll") for (int n = 0; n < 2; ++n) { \
        if constexpr (F8) { acc[ai][bj][m][n] = __builtin_amdgcn_mfma_scale_f32_16x16x128_f8f6f4(PG8_CAT(Bt[n][0], Bt[n][1]), PG8_CAT(At[m][0], At[m][1]), acc[ai][bj][m][n], 0, 0, 0, 0x7F7F7F7F, 0, 0x7F7F7F7F); } \
        else { _Pragma("unroll") for (int k = 0; k < 2; ++k) acc[ai][bj][m][n] = __builtin_amdgcn_mfma_f32_16x16x32_bf16(__builtin_bit_cast(bf16x8, Bt[n][k]), __builtin_bit_cast(bf16x8, At[m][k]), acc[ai][bj][m][n], 0, 0, 0); } } __builtin_amdgcn_s_setprio(0); } while (0)
#define PG8_WAIT_V(n) asm volatile("s_waitcnt vmcnt(" #n ")" ::: "memory")
#define PG8_WAIT_L(n) asm volatile("s_waitcnt lgkmcnt(" #n ")" ::: "memory")
#define PG8_BAR __builtin_amdgcn_s_barrier()
#define PG8_SCHED __builtin_amdgcn_sched_barrier(0)
    Unit cur, nxt; int ui = 0;
    if (!S.next(0, cur)) return;
    f32x4 acc[2][2][4][2];
#pragma unroll
    for (int a = 0; a < 2; ++a)
#pragma unroll
        for (int b = 0; b < 2; ++b)
#pragma unroll
            for (int m = 0; m < 4; ++m)
#pragma unroll
                for (int n = 0; n < 2; ++n) acc[a][b][m][n] = (f32x4){0.f, 0.f, 0.f, 0.f};
    v4i32 At[4][2], B0[2][2], B1[2][2];
    const char* cA = (const char*)g.A + (size_t)cur.pm * tstep; const char* cB = (const char*)g.Bt + (size_t)cur.pn * tstep;
    S.a_ready(cur);
    if constexpr (SP2) {
        PG8_STAGE(PG8_SB(0, 0), cB, voffB); PG8_STAGE(PG8_SB(0, 1), cB + hstep, voffB); PG8_STAGE(PG8_SA(0, 0), cA, voffA); PG8_STAGE(PG8_SA(0, 1), cA + hstep, voffA);
        if (wr == 1) PG8_BAR;
        PG8_WAIT_V(2); PG8_BAR;
        PG8_STAGE(PG8_SB(1, 0), cB + kstep, voffB); PG8_STAGE(PG8_SA(1, 0), cA + kstep, voffA); PG8_STAGE(PG8_SB(1, 1), cB + hstep + kstep, voffB);
        PG8_WAIT_V(6); PG8_BAR;
    } else {
        PG8_STAGE(PG8_SB(0, 0), cB, voffB); PG8_STAGE(PG8_SA(0, 0), cA, voffA); PG8_STAGE(PG8_SB(0, 1), cB + hstep, voffB); PG8_STAGE(PG8_SA(0, 1), cA + hstep, voffA);
        if (wr == 1) PG8_BAR;
        PG8_WAIT_V(4); PG8_BAR;
        PG8_STAGE(PG8_SB(1, 0), cB + kstep, voffB); PG8_STAGE(PG8_SA(1, 0), cA + kstep, voffA); PG8_STAGE(PG8_SB(1, 1), cB + hstep + kstep, voffB);
        PG8_WAIT_V(6); PG8_BAR;
    }
    for (;;) {
        const bool has_next = S.next(ui + 1, nxt);
        const char* nA = has_next ? (const char*)g.A + (size_t)nxt.pm * tstep : cA; const char* nB = has_next ? (const char*)g.Bt + (size_t)nxt.pn * tstep : cB;
#pragma unroll 1
        for (int t = 0; t < nt; t += 2) {
            const bool last = (t == nt - 2);
            const char* a1 = cA + (size_t)(t + 1) * kstep;
            const char* a2 = last ? nA : cA + (size_t)(t + 2) * kstep; const char* b2 = last ? nB : cB + (size_t)(t + 2) * kstep;
            const char* a3 = a2 + kstep; const char* b3 = b2 + kstep;
            if (last && has_next) S.a_ready(nxt);
            if constexpr (SP2) {
            PG8_LDB(B0, 0, 0); PG8_LDB(B1, 0, 1); PG8_SCHED; PG8_LDA(At, 0, 0); PG8_STAGE(PG8_SA(1, 1), a1 + hstep, voffA);
            PG8_WAIT_V(8); PG8_WAIT_L(0); PG8_BAR; PG8_MMA(0, 0, At, B0); PG8_MMA(0, 1, At, B1); PG8_BAR; PG8_SCHED;
            PG8_LDA(At, 0, 1); PG8_STAGE(PG8_SB(0, 0), b2, voffB); PG8_STAGE(PG8_SB(0, 1), b2 + hstep, voffB); PG8_STAGE(PG8_SA(0, 0), a2, voffA);
            PG8_WAIT_V(8); PG8_WAIT_L(0); PG8_BAR; PG8_MMA(1, 0, At, B0); PG8_MMA(1, 1, At, B1); PG8_BAR; PG8_SCHED;
            PG8_LDB(B0, 1, 0); PG8_LDB(B1, 1, 1); PG8_SCHED; PG8_LDA(At, 1, 0); PG8_STAGE(PG8_SA(0, 1), a2 + hstep, voffA);
            PG8_WAIT_V(8); PG8_WAIT_L(0); PG8_BAR; PG8_MMA(0, 0, At, B0); PG8_MMA(0, 1, At, B1); PG8_BAR; PG8_SCHED;
            PG8_LDA(At, 1, 1); PG8_STAGE(PG8_SB(1, 0), b3, voffB); PG8_STAGE(PG8_SB(1, 1), b3 + hstep, voffB); PG8_STAGE(PG8_SA(1, 0), a3, voffA);
            PG8_WAIT_V(8); PG8_WAIT_L(0); PG8_BAR; PG8_MMA(1, 0, At, B0); PG8_MMA(1, 1, At, B1); PG8_BAR; PG8_SCHED;
            } else {
            PG8_LDB(B0, 0, 0); PG8_SCHED; PG8_LDA(At, 0, 0); PG8_STAGE(PG8_SA(1, 1), a1 + hstep, voffA);
            PG8_WAIT_L(8); PG8_BAR; PG8_WAIT_L(0); PG8_MMA(0, 0, At, B0); PG8_BAR; PG8_SCHED;
            PG8_LDB(B1, 0, 1); PG8_STAGE(PG8_SB(0, 0), b2, voffB);
            PG8_BAR; PG8_WAIT_L(0); PG8_MMA(0, 1, At, B1); PG8_BAR;
            PG8_LDA(At, 0, 1); PG8_STAGE(PG8_SA(0, 0), a2, voffA);
            PG8_BAR; PG8_WAIT_L(0); PG8_MMA(1, 0, At, B0); PG8_BAR; PG8_SCHED;
            PG8_STAGE(PG8_SB(0, 1), b2 + hstep, voffB);
            PG8_WAIT_V(6); PG8_BAR; PG8_MMA(1, 1, At, B1); PG8_BAR;
            PG8_LDB(B0, 1, 0); PG8_SCHED; PG8_LDA(At, 1, 0); PG8_STAGE(PG8_SA(0, 1), a2 + hstep, voffA);
            PG8_WAIT_L(8); PG8_BAR; PG8_WAIT_L(0); PG8_MMA(0, 0, At, B0); PG8_BAR; PG8_SCHED;
            PG8_LDB(B1, 1, 1); PG8_STAGE(PG8_SB(1, 0), b3, voffB);
            PG8_BAR; PG8_WAIT_L(0); PG8_MMA(0, 1, At, B1); PG8_BAR;
            PG8_LDA(At, 1, 1); PG8_STAGE(PG8_SA(1, 0), a3, voffA);
            PG8_BAR; PG8_WAIT_L(0); PG8_MMA(1, 0, At, B0); PG8_BAR; PG8_SCHED;
            PG8_STAGE(PG8_SB(1, 1), b3 + hstep, voffB);
            PG8_WAIT_V(6); PG8_BAR; PG8_MMA(1, 1, At, B1); PG8_BAR;
            }
        }
        if constexpr (ALIGN_EPI) { if (wr == 0) PG8_BAR; }
        if constexpr (!Epi::AFTER_DRAIN) { E(acc, cur, wr, wc, fr, fq); S.done(cur); }
        if (!has_next) break;
#pragma unroll
        for (int a = 0; a < 2; ++a)
#pragma unroll
            for (int b = 0; b < 2; ++b)
#pragma unroll
                for (int m = 0; m < 4; ++m)
#pragma unroll
                    for (int n = 0; n < 2; ++n) acc[a][b][m][n] = (f32x4){0.f, 0.f, 0.f, 0.f};
        cur = nxt; cA = nA; cB = nB; ++ui;
        if constexpr (ALIGN_EPI) { if (wr == 1) PG8_BAR; }
    }
    PG8_WAIT_V(0);
    if constexpr (!ALIGN_EPI) { if (wr == 0) PG8_BAR; }
    PG8_BAR;
    if constexpr (Epi::AFTER_DRAIN) { E.fused(acc, cur, wr, wc, fr, fq, lds, wid, lane); S.done(cur); }
#undef PG8_SA
#undef PG8_SB
#undef PG8_STAGE
#undef PG8_GLDS
#undef PG8_LDA
#undef PG8_LDB
#undef PG8_MMA
#undef PG8_CAT
#undef PG8_WAIT_V
#undef PG8_WAIT_L
#undef PG8_BAR
#undef PG8_SCHED
}
}
namespace cg = cooperative_groups;
#define LAS __attribute__((address_space(3)))
typedef unsigned short bf16_t;
typedef short bf16x8 __attribute__((ext_vector_type(8)));
typedef short s16x4 __attribute__((ext_vector_type(4)));
typedef short v4i16_t __attribute__((ext_vector_type(4)));
typedef float f32x4 __attribute__((ext_vector_type(4)));
typedef float f32x16 __attribute__((ext_vector_type(16)));
typedef unsigned u32x4 __attribute__((ext_vector_type(4)));
typedef unsigned u32x2 __attribute__((ext_vector_type(2)));

constexpr int NWAVES = 8, NTHR = 512;
constexpr int D = 1024, SEQ = 2048, NBATCH = 32, FF = 2816, NPROJ = 3072;
constexpr int MP = 65536, MS = 128, MV = MP + MS, MPAD = 65792;
constexpr float EPS = 1e-6f;
constexpr int LDS_BYTES = 147456;
constexpr size_t O_Y = 0, O_KP = 67239936, O_VP = O_KP + 33554432, O_CP = O_VP + 33554432, O_NP = O_CP + 1048576, O_MPR = O_NP + 8192,
                 O_KS = O_MPR + 128, O_VS = O_KS + 65536, O_CS = O_VS + 65536, O_NS = O_CS + 262144, O_MS = O_NS + 2048, O_END = O_MS + 32;
constexpr size_t MiB = 1u << 20;
constexpr size_t WS_CTL = 0, WS_MOD = 1 * MiB, WS_ROPE = 3 * MiB, WS_GATES = 4 * MiB, WS_W1I = 8 * MiB, WS_W1O = 20 * MiB, WS_WIN = 26 * MiB, WS_WO = 32 * MiB,
                 WS_W2I = 34 * MiB, WS_W2O = 46 * MiB, WS_SK = 52 * MiB, WS_SV = 61 * MiB, WS_H = 72 * MiB, WS_F = 202 * MiB, WS_P = 332 * MiB, WS_W1I8 = 720 * MiB, WS_W2I8 = 726 * MiB, WS_W2O8 = 732 * MiB, WS_X16 = 736 * MiB, WS_END = 866 * MiB;
constexpr float H8_SCALE = 8.0f, W8_SCALE = 256.0f, A8_SCALE = 4.0f;

typedef float f32x2c __attribute__((ext_vector_type(2))); typedef __bf16 bf16x2c __attribute__((ext_vector_type(2)));
__device__ __forceinline__ unsigned pk2(float lo, float hi) { const f32x2c v = {lo, hi}; return __builtin_bit_cast(unsigned, __builtin_convertvector(v, bf16x2c)); }
__device__ __forceinline__ unsigned f2bf(float f) { return pk2(f, f) & 0xffffu; }
__device__ __forceinline__ float bflo(unsigned u) { return __uint_as_float(u << 16); }
__device__ __forceinline__ float bfhi(unsigned u) { return __uint_as_float(u & 0xffff0000u); }
__device__ __forceinline__ float wave_sum(float v) {
#pragma unroll
    for (int o = 1; o < 64; o <<= 1) v += __shfl_xor(v, o);
    return v;
}
__device__ __forceinline__ int crow(int r, int hi) { return (r & 3) + 8 * (r >> 2) + 4 * hi; }

struct Args { const float* in[23]; float* out; unsigned char* ws; int ph_lo, ph_hi; };

__device__ __forceinline__ unsigned pk4_fp8(float a, float b, float c, float d) { unsigned p = 0u; p = __builtin_amdgcn_cvt_pk_fp8_f32(a, b, p, false); p = __builtin_amdgcn_cvt_pk_fp8_f32(c, d, p, true); return p; }
__device__ __forceinline__ void p0_transpose_item(const float* W, int K, int N, bf16_t* WT, int k0, int sc0, int dr0, LAS float* scr, int lane, unsigned char* WT8 = nullptr) {
    float wv[32];
#pragma unroll
    for (int i = 0; i < 32; ++i) wv[i] = W[(size_t)(k0 + 2 * i + (lane >> 5)) * N + sc0 + (lane & 31)];
#pragma unroll
    for (int i = 0; i < 32; ++i) scr[(2 * i + (lane >> 5)) * 33 + (lane & 31)] = wv[i];
    asm volatile("s_waitcnt lgkmcnt(0)" ::: "memory");
    const int c = lane & 7;
#pragma unroll
    for (int j = 0; j < 4; ++j) { const int n = (lane >> 3) + 8 * j; const LAS float* s = scr + (8 * c) * 33 + n;
        u32x4 o; o.x = pk2(s[0 * 33], s[1 * 33]); o.y = pk2(s[2 * 33], s[3 * 33]); o.z = pk2(s[4 * 33], s[5 * 33]); o.w = pk2(s[6 * 33], s[7 * 33]);
        *(u32x4*)(WT + (size_t)(dr0 + n) * K + k0 + 8 * c) = o; }
    if (WT8) {
        const int c4 = lane & 3;
#pragma unroll
        for (int j = 0; j < 2; ++j) { const int n = (lane >> 2) + 16 * j; const LAS float* s = scr + (16 * c4) * 33 + n;
            u32x4 o; o.x = pk4_fp8(s[0] * W8_SCALE, s[33] * W8_SCALE, s[66] * W8_SCALE, s[99] * W8_SCALE); o.y = pk4_fp8(s[132] * W8_SCALE, s[165] * W8_SCALE, s[198] * W8_SCALE, s[231] * W8_SCALE);
            o.z = pk4_fp8(s[264] * W8_SCALE, s[297] * W8_SCALE, s[330] * W8_SCALE, s[363] * W8_SCALE); o.w = pk4_fp8(s[396] * W8_SCALE, s[429] * W8_SCALE, s[462] * W8_SCALE, s[495] * W8_SCALE);
            *(u32x4*)(WT8 + (size_t)(dr0 + n) * K + k0 + 16 * c4) = o; }
    }
    asm volatile("s_waitcnt lgkmcnt(0)" ::: "memory");
}
__device__ __forceinline__ int ffn_in_src(int dr0) { const int tile = dr0 >> 8, w0 = dr0 & 255; return (w0 < 128) ? (128 * tile + w0) : (FF + 128 * tile + w0 - 128); }

__device__ __forceinline__ void p0_prologue(const Args& a, LAS unsigned char* lds) {
    int tid = threadIdx.x; asm volatile("" : "+v"(tid));
    const int lane = tid & 63, wave = __builtin_amdgcn_readfirstlane(tid >> 6);
    const int G = gridDim.x;
    unsigned char* ws = a.ws;
    if (blockIdx.x == 0 && wave == 0) {
        const float* lq = a.in[19];
        float a0 = lq[lane] * lq[64 + lane], a1 = lq[128 + lane] * lq[192 + lane];
        a0 = wave_sum(a0); a1 = wave_sum(a1);
        if (lane == 0) { ((float*)(ws + WS_CTL))[64] = __expf(a0) - __expf(a1) + 0.2f; }
    }
    {
        const float* cp = a.in[7]; const float* csm = a.in[8]; const float* wada = a.in[9]; const float* bada = a.in[10];
        float* mod = (float*)(ws + WS_MOD);
        LAS float* sct = (LAS float*)lds;
        LAS float* red = (LAS float*)(lds + 81920);
        for (int it = blockIdx.x; it < 576; it += G) {
            const int cgp = it >> 1, rh = it & 1;
            for (int i = tid; i < 20480; i += NTHR) { const int rr = i >> 10, k = i & 1023, grow = 20 * rh + rr;
                const float c = grow < 32 ? cp[grow * 1024 + k] : csm[(grow - 32) * 1024 + k];
                sct[k * 20 + rr] = c * __builtin_amdgcn_rcpf(1.0f + __expf(-c)); }
            __syncthreads();
            const int col = tid & 31, ks = tid >> 5;
            float acc[20];
#pragma unroll
            for (int r = 0; r < 20; ++r) acc[r] = 0.f;
            const float* wp = wada + (size_t)(64 * ks) * 9216 + 32 * cgp + col;
            float wv[64];
#pragma unroll
            for (int kk = 0; kk < 64; ++kk) wv[kk] = wp[(size_t)kk * 9216];
#pragma unroll
            for (int kk = 0; kk < 64; ++kk) {
                const float w = wv[kk];
                const LAS f32x4* s4 = (const LAS f32x4*)(sct + (64 * ks + kk) * 20);
#pragma unroll
                for (int q = 0; q < 5; ++q) { const f32x4 s = s4[q]; acc[4 * q] += s[0] * w; acc[4 * q + 1] += s[1] * w; acc[4 * q + 2] += s[2] * w; acc[4 * q + 3] += s[3] * w; }
            }
#pragma unroll
            for (int r = 0; r < 20; ++r) red[(ks * 20 + r) * 32 + col] = acc[r];
            __syncthreads();
            for (int i = tid; i < 640; i += NTHR) { const int r = i >> 5, c2 = i & 31; float s = bada[32 * cgp + c2];
#pragma unroll
                for (int k2 = 0; k2 < 16; ++k2) s += red[(k2 * 20 + r) * 32 + c2];
                mod[(size_t)(20 * rh + r) * 9216 + 32 * cgp + c2] = s; }
            __syncthreads();
        }
    }
    {
        LAS float* scr = (LAS float*)(lds + wave * 16384);
        const int gw = blockIdx.x * NWAVES + wave, NGW = G * NWAVES;
        constexpr int I_1I = 16 * 176, I_1O = 44 * 32, I_IN = 16 * 96, I_O = 16 * 32;
        constexpr int NITEMS = 2 * I_1I + 2 * I_1O + I_IN + I_O;
        for (int it = gw; it < NITEMS; it += NGW) {
            int r = it;
            if (r < I_1I) { const int kb = r / 176, nb = r % 176; p0_transpose_item(a.in[12], D, 2 * FF, (bf16_t*)(ws + WS_W1I), 64 * kb, ffn_in_src(32 * nb), 32 * nb, scr, lane); continue; } r -= I_1I;
            if (r < I_1I) { const int kb = r / 176, nb = r % 176; p0_transpose_item(a.in[21], D, 2 * FF, (bf16_t*)(ws + WS_W2I), 64 * kb, ffn_in_src(32 * nb), 32 * nb, scr, lane, ws + WS_W2I8); continue; } r -= I_1I;
            if (r < I_1O) { const int kb = r / 32, nb = r % 32; p0_transpose_item(a.in[13], FF, D, (bf16_t*)(ws + WS_W1O), 64 * kb, 32 * nb, 32 * nb, scr, lane); continue; } r -= I_1O;
            if (r < I_1O) { const int kb = r / 32, nb = r % 32; p0_transpose_item(a.in[22], FF, D, (bf16_t*)(ws + WS_W2O), 64 * kb, 32 * nb, 32 * nb, scr, lane, ws + WS_W2O8); continue; } r -= I_1O;
            if (r < I_IN) { const int kb = r / 96, nb = r % 96; p0_transpose_item(a.in[14], D, 3080, (bf16_t*)(ws + WS_WIN), 64 * kb, 32 * nb + (nb >= 48 ? 8 : 0), 32 * nb, scr, lane); continue; } r -= I_IN;
            { const int kb = r / 32, nb = r % 32; p0_transpose_item(a.in[20], D, D, (bf16_t*)(ws + WS_WO), 64 * kb, 32 * nb, 32 * nb, scr, lane); }
        }
    }
    {
        const int gt = blockIdx.x * NTHR + tid, NGT = G * NTHR;
        for (int i = gt; i < 2 * 524288; i += NGT) {
            const int ten = i >> 19, j = i & 524287, b = j >> 16, rem = j & 65535, pos = rem >> 6, ch = rem & 63;
            const float* src = a.in[2 + ten] + ((size_t)(b * 1024 + pos) * 512 + ch * 8);
            const f32x4 x0 = *(const f32x4*)src, x1 = *(const f32x4*)(src + 4);
            u32x4 o; o.x = pk2(x0[0], x0[1]); o.y = pk2(x0[2], x0[3]); o.z = pk2(x1[0], x1[1]); o.w = pk2(x1[2], x1[3]);
            *(u32x4*)((bf16_t*)(ws + (ten ? WS_SV : WS_SK)) + ((size_t)(b * 1088 + pos) * 512 + ch * 8)) = o;
        }
        float* rope = (float*)(ws + WS_ROPE);
        for (int i = gt; i < 2048 * 8; i += NGT) {
            const int pos = i >> 3, fi = i & 7;
            const double invf = fi == 0 ? 1.0 : fi == 1 ? 0.19392274474868576 : fi == 2 ? 0.03760603093086393 : fi == 3 ? 0.007292664737217109 : fi == 4 ? 0.001414213562373095
                              : fi == 5 ? 0.0002742481756762073 : fi == 6 ? 5.318295896944988e-05 : 1.031338537721246e-05;
            const double ang = (double)pos * invf;
            const double n = __builtin_rint(ang * 0.15915494309189535);
            const double rr = __builtin_fma(-n, 6.283185307179586, ang);
            const double kq = __builtin_rint(rr * 0.6366197723675814);
            const double y = __builtin_fma(-kq, 1.5707963267948966, rr), y2 = y * y;
            const double sn = y * (1.0 - y2 / 6.0 * (1.0 - y2 / 20.0 * (1.0 - y2 / 42.0 * (1.0 - y2 / 72.0 * (1.0 - y2 / 110.0 * (1.0 - y2 / 156.0))))));
            const double cs = 1.0 - y2 / 2.0 * (1.0 - y2 / 12.0 * (1.0 - y2 / 30.0 * (1.0 - y2 / 56.0 * (1.0 - y2 / 90.0 * (1.0 - y2 / 132.0)))));
            const int q = ((int)kq) & 3;
            const double c = q == 0 ? cs : q == 1 ? -sn : q == 2 ? -cs : sn;
            const double s = q == 0 ? sn : q == 1 ? cs : q == 2 ? -sn : -cs;
            rope[pos * 16 + fi] = (float)c; rope[pos * 16 + 8 + fi] = (float)s;
        }
    }
}

template <bool HAS_F, bool HAS_H, bool GATES, bool H8 = false  , bool XIN16 = false, bool XOUT16 = false  >
__device__ __forceinline__ void row_phase(const Args& a, LAS unsigned char* lds, const float* xin_p, const float* xin_s, float* xout, int kg, float rw, int gpost, int gpre, int ksh, int ksc) {
    int tid = threadIdx.x; asm volatile("" : "+v"(tid));
    const int lane = tid & 63, wave = __builtin_amdgcn_readfirstlane(tid >> 6);
    const int gw = blockIdx.x * NWAVES + wave, NGW = gridDim.x * NWAVES;
    unsigned char* ws = a.ws;
    const float* mod = (const float*)(ws + WS_MOD);
    const float* gn = a.in[11];
    const bf16_t* F = (const bf16_t*)(ws + WS_F);
    bf16_t* H = (bf16_t*)(ws + WS_H); bf16_t* X16 = (bf16_t*)(ws + WS_X16);
    float* gates = (float*)(ws + WS_GATES);
    LAS float* wg = (LAS float*)lds;
    if (GATES) {
        const float* win = a.in[14];
        for (int i = tid; i < 8192; i += NTHR) wg[i] = win[(size_t)(i >> 3) * 3080 + 1536 + (i & 7)];
        __syncthreads();
    }
    if (HAS_H && !HAS_F) {
        for (int i = blockIdx.x * NTHR + tid; i < (MPAD - MV) * D / 8; i += gridDim.x * NTHR) *(u32x4*)(H + (size_t)MV * D + (size_t)i * 8) = (u32x4){0u, 0u, 0u, 0u};
    }
    for (int ch = gw; ch < 2048 + MS; ch += NGW) {
        const bool samp = ch >= 2048;
        const int row0 = samp ? MP + (ch - 2048) : ch * 32, nrows = samp ? 1 : 32;
        const int mb = samp ? 32 + ((ch - 2048) >> 4) : (ch >> 6);
        const float* mrow = mod + (size_t)mb * 9216;
        f32x4 A1[4], A2[4], A3[4];
#pragma unroll
        for (int j = 0; j < 4; ++j) {
            const int e = 4 * lane + 256 * j;
            if (HAS_F && !GATES) { const f32x4 mg = *(const f32x4*)(mrow + kg * 1024 + e), gp = *(const f32x4*)(gn + gpost * 1024 + e); A1[j] = mg * gp * rw; }
            if (HAS_H) { const f32x4 gp = *(const f32x4*)(gn + gpre * 1024 + e), sc = *(const f32x4*)(mrow + ksc * 1024 + e); A2[j] = gp * (sc + 1.0f); if (!GATES) A3[j] = *(const f32x4*)(mrow + ksh * 1024 + e); }
        }
        for (int rr = 0; rr < nrows; ++rr) {
            const int row = row0 + rr;
            const float* xr = samp ? xin_s + (size_t)(row - MP) * D : xin_p + (size_t)row * D;
            f32x4 x[4];
#pragma unroll
            for (int j = 0; j < 4; ++j) {
                if (XIN16) { const u32x2 u = *(const u32x2*)(X16 + (size_t)row * D + 4 * lane + 256 * j); x[j] = (f32x4){bflo(u.x), bfhi(u.x), bflo(u.y), bfhi(u.y)}; }
                else x[j] = *(const f32x4*)(xr + 4 * lane + 256 * j);
            }
            if (HAS_F) {
                f32x4 f[4]; float ss = 0.f;
#pragma unroll
                for (int j = 0; j < 4; ++j) { const u32x2 u = *(const u32x2*)(F + (size_t)row * D + 4 * lane + 256 * j);
                    f[j] = (f32x4){bflo(u.x), bfhi(u.x), bflo(u.y), bfhi(u.y)}; ss += (f[j][0] * f[j][0] + f[j][1] * f[j][1]) + (f[j][2] * f[j][2] + f[j][3] * f[j][3]); }
                const float rstd = __builtin_amdgcn_rsqf(wave_sum(ss) * (1.0f / D) + EPS);
#pragma unroll
                for (int j = 0; j < 4; ++j) { f32x4 a1; if (GATES) { const int e = 4 * lane + 256 * j; a1 = *(const f32x4*)(mrow + kg * 1024 + e) * *(const f32x4*)(gn + gpost * 1024 + e) * rw; } else a1 = A1[j];
                    x[j] = x[j] + a1 * f[j] * rstd;
                    if (XOUT16) { u32x2 o; o.x = pk2(x[j][0], x[j][1]); o.y = pk2(x[j][2], x[j][3]); *(u32x2*)(X16 + (size_t)row * D + 4 * lane + 256 * j) = o; }
                    else *(f32x4*)(xout + (size_t)row * D + 4 * lane + 256 * j) = x[j]; }
            }
            if (HAS_H) {
                float ss = 0.f;
#pragma unroll
                for (int j = 0; j < 4; ++j) ss += (x[j][0] * x[j][0] + x[j][1] * x[j][1]) + (x[j][2] * x[j][2] + x[j][3] * x[j][3]);
                const float rstd = __builtin_amdgcn_rsqf(wave_sum(ss) * (1.0f / D) + EPS);
                f32x4 h[4];
#pragma unroll
                for (int j = 0; j < 4; ++j) { const f32x4 sh = GATES ? *(const f32x4*)(mrow + ksh * 1024 + 4 * lane + 256 * j) : A3[j]; h[j] = x[j] * rstd * A2[j] + sh;
                    if (H8 && !samp) { *(unsigned*)((unsigned char*)H + (size_t)row * D + 4 * lane + 256 * j) = pk4_fp8(h[j][0] * H8_SCALE, h[j][1] * H8_SCALE, h[j][2] * H8_SCALE, h[j][3] * H8_SCALE); }
                    else { u32x2 o; o.x = pk2(h[j][0], h[j][1]); o.y = pk2(h[j][2], h[j][3]); *(u32x2*)(H + (size_t)row * D + 4 * lane + 256 * j) = o; } }
                if (GATES) {
                    float g[8];
#pragma unroll
                    for (int q = 0; q < 8; ++q) g[q] = 0.f;
#pragma unroll
                    for (int j = 0; j < 4; ++j)
#pragma unroll
                        for (int e = 0; e < 4; ++e) { const LAS f32x4* wp = (const LAS f32x4*)(wg + (4 * lane + 256 * j + e) * 8); const f32x4 w0 = wp[0], w1 = wp[1]; const float hv = h[j][e];
                            g[0] += hv * w0[0]; g[1] += hv * w0[1]; g[2] += hv * w0[2]; g[3] += hv * w0[3]; g[4] += hv * w1[0]; g[5] += hv * w1[1]; g[6] += hv * w1[2]; g[7] += hv * w1[3]; }
#pragma unroll
                    for (int q = 0; q < 8; ++q) g[q] = wave_sum(g[q]);
                    const float gsel = lane == 0 ? g[0] : lane == 1 ? g[1] : lane == 2 ? g[2] : lane == 3 ? g[3] : lane == 4 ? g[4] : lane == 5 ? g[5] : lane == 6 ? g[6] : g[7];
                    if (lane < 8) {
                        float v;
                        if (lane < 4) v = gsel + a.in[15][lane];
                        else { const float z = gsel + a.in[16][lane - 4]; v = fminf(z, 0.f) - log1pf(__expf(-fabsf(z))); }
                        gates[(size_t)row * 8 + lane] = v;
                    }
                }
            }
        }
    }
}
typedef LAS unsigned char* ldsp;
__device__ __forceinline__ bf16x8 lds_frag(ldsp p) { return *(const LAS bf16x8*)p; }
__device__ __forceinline__ s16x4 vtr(ldsp p) { return __builtin_bit_cast(s16x4, __builtin_amdgcn_ds_read_tr16_b64_v4i16((LAS v4i16_t*)p)); }
__device__ __forceinline__ bf16x8 vtr2(ldsp p) { const s16x4 lo = vtr(p), hi = vtr(p + 512); return (bf16x8){lo[0], lo[1], lo[2], lo[3], hi[0], hi[1], hi[2], hi[3]}; }
__device__ __forceinline__ bf16x8 pack8(const f32x16& p, int s) {
    u32x4 w; w.x = pg8::cvt_pk_bf16(p[8 * s + 0], p[8 * s + 1]); w.y = pg8::cvt_pk_bf16(p[8 * s + 2], p[8 * s + 3]); w.z = pg8::cvt_pk_bf16(p[8 * s + 4], p[8 * s + 5]); w.w = pg8::cvt_pk_bf16(p[8 * s + 6], p[8 * s + 7]);
    return __builtin_bit_cast(bf16x8, w);
}
__device__ __forceinline__ int rimg(int row, int c, int nrows) { return c * nrows * 16 + ((row ^ (c & 7)) * 16); }
__device__ __forceinline__ int timg(int s, int c16) { return (c16 >> 2) * 4096 + (s >> 3) * 512 + (s & 7) * 64 + (c16 & 3) * 16; }

constexpr float LOG2E = 1.4426950408889634f;
__device__ __forceinline__ float max3f(float a, float b, float c) { float r; asm("v_max3_f32 %0, %1, %2, %3" : "=v"(r) : "v"(a), "v"(b), "v"(c)); return r; }
constexpr float AT_THR = 8.0f;
constexpr int AT_Q = 0, AT_KV = 32768, AT_KVB = 32768, AT_V = 16384, AT_X = 0;

__device__ __forceinline__ void attn_unit(ldsp lds, const bf16_t* Qg, int qstride, int nq_valid, const bf16_t* Kg, const bf16_t* Vg, int kvstride, int NT, int lim, int nvalid_last,
                                          bf16_t* Og, const float* gd, float lam) {
    int tid = threadIdx.x; asm volatile("" : "+v"(tid));
    const int lane = tid & 63, w = __builtin_amdgcn_readfirstlane(tid >> 6), r32 = lane & 31, hi = lane >> 5;
    const int rg = w >> 1, c = w & 1;
#pragma unroll
    for (int i = 0; i < 4; ++i) { const int id = tid + NTHR * i, row = id >> 4, c16 = id & 15, srow = row < nq_valid ? row : 0;
        const u32x4 v = *(const u32x4*)(Qg + (size_t)srow * qstride + c16 * 8);
        *(LAS u32x4*)(lds + AT_Q + rimg(row, c16, 128)) = v; }
    const int key0 = tid >> 4, cc = tid & 15;
    const bf16_t* kp = Kg + (size_t)key0 * kvstride + cc * 8; const bf16_t* vp = Vg + (size_t)key0 * kvstride + cc * 8;
    u32x4 kr0, kr1, vr0, vr1;
    kr0 = *(const u32x4*)kp; kr1 = *(const u32x4*)(kp + (size_t)32 * kvstride); vr0 = *(const u32x4*)vp; vr1 = *(const u32x4*)(vp + (size_t)32 * kvstride);
    f32x16 O[4];
#pragma unroll
    for (int d = 0; d < 4; ++d)
#pragma unroll
        for (int r = 0; r < 16; ++r) O[d][r] = 0.f;
    float lrun = 0.f;
    f32x16 negm;
#pragma unroll
    for (int r = 0; r < 16; ++r) negm[r] = 0.f;
    const int vlane = ((lane >> 4) & 1) * 32 + (lane & 3) * 8 + (4 * hi + ((lane & 15) >> 2)) * 64;
    for (int j = 0; j < NT; ++j) {
        const ldsp kb = lds + AT_KV + (j & 1) * AT_KVB; const ldsp vb = kb + AT_V;
        *(LAS u32x4*)(kb + rimg(key0, cc, 64)) = kr0; *(LAS u32x4*)(kb + rimg(key0 + 32, cc, 64)) = kr1;
        *(LAS u32x4*)(vb + timg(key0, cc)) = vr0; *(LAS u32x4*)(vb + timg(key0 + 32, cc)) = vr1;
        __syncthreads();
        if (j + 1 < NT) { const size_t o = (size_t)(64 * (j + 1)) * kvstride;
            kr0 = *(const u32x4*)(kp + o); kr1 = *(const u32x4*)(kp + o + (size_t)32 * kvstride); vr0 = *(const u32x4*)(vp + o); vr1 = *(const u32x4*)(vp + o + (size_t)32 * kvstride); }
        if (j <= lim) {
            const bool maskt = (j == NT - 1) && (nvalid_last < 64);
            f32x16 s0 = negm, s1 = negm;
#pragma unroll
            for (int st = 0; st < 4; ++st) {
                const int c16 = 8 * c + 2 * st + hi;
                const bf16x8 qf = lds_frag(lds + AT_Q + rimg(32 * rg + r32, c16, 128));
                const bf16x8 k0 = lds_frag(kb + rimg(r32, c16, 64)), k1 = lds_frag(kb + rimg(32 + r32, c16, 64));
                s0 = __builtin_amdgcn_mfma_f32_32x32x16_bf16(k0, qf, s0, 0, 0, 0);
                s1 = __builtin_amdgcn_mfma_f32_32x32x16_bf16(k1, qf, s1, 0, 0, 0);
            }
            if (maskt) {
#pragma unroll
                for (int r = 0; r < 16; ++r) { const int key = crow(r, hi); if (key >= nvalid_last) s0[r] = -INFINITY; if (key + 32 >= nvalid_last) s1[r] = -INFINITY; }
            }
            float mx = -INFINITY;
#pragma unroll
            for (int r = 0; r < 16; ++r) mx = max3f(mx, s0[r], s1[r]);
            mx = fmaxf(mx, __shfl_xor(mx, 32));
            if (j == 0 || __builtin_amdgcn_ballot_w64(mx > AT_THR) != 0ull) {
                const float delta = (j == 0) ? mx : fmaxf(mx, 0.f);
                const float alpha = (j == 0) ? 1.0f : __builtin_amdgcn_exp2f(-delta);
                lrun *= alpha;
#pragma unroll
                for (int r = 0; r < 16; ++r) { negm[r] -= delta; s0[r] -= delta; s1[r] -= delta; }
#pragma unroll
                for (int d = 0; d < 4; ++d)
#pragma unroll
                    for (int r = 0; r < 16; ++r) O[d][r] *= alpha;
            }
            float rs = 0.f;
#pragma unroll
            for (int r = 0; r < 16; ++r) { s0[r] = __builtin_amdgcn_exp2f(s0[r]); s1[r] = __builtin_amdgcn_exp2f(s1[r]); rs += s0[r] + s1[r]; }
            rs += __shfl_xor(rs, 32);
            lrun += rs;
            const bf16x8 pf0 = pack8(s0, 0), pf1 = pack8(s0, 1), pf2 = pack8(s1, 0), pf3 = pack8(s1, 1);
#pragma unroll
            for (int d = 0; d < 4; ++d) {
                const ldsp vq = vb + vlane + d * 4096;
                O[d] = __builtin_amdgcn_mfma_f32_32x32x16_bf16(vtr2(vq), pf0, O[d], 0, 0, 0);
                O[d] = __builtin_amdgcn_mfma_f32_32x32x16_bf16(vtr2(vq + 1024), pf1, O[d], 0, 0, 0);
                O[d] = __builtin_amdgcn_mfma_f32_32x32x16_bf16(vtr2(vq + 2048), pf2, O[d], 0, 0, 0);
                O[d] = __builtin_amdgcn_mfma_f32_32x32x16_bf16(vtr2(vq + 3072), pf3, O[d], 0, 0, 0);
            }
        }
    }
    __syncthreads();
    LAS float* xch = (LAS float*)(lds + AT_X) + rg * 4096 + lane;
    if (lim >= 0 && c == 1) {
        const float i1 = lam / lrun;
#pragma unroll
        for (int d = 0; d < 4; ++d)
#pragma unroll
            for (int r = 0; r < 16; ++r) xch[(d * 16 + r) * 64] = O[d][r] * i1;
    }
    __syncthreads();
    if (lim >= 0 && c == 0) {
        const float i0 = 1.0f / lrun;
        float ss = 0.f;
#pragma unroll
        for (int d = 0; d < 4; ++d)
#pragma unroll
            for (int r = 0; r < 16; ++r) { const float o = O[d][r] * i0 - xch[(d * 16 + r) * 64]; O[d][r] = o; ss += o * o; }
        ss += __shfl_xor(ss, 32);
        const float rstd = __builtin_amdgcn_rsqf(ss * (1.0f / 128.0f) + EPS) * 0.8f;
        const int q = 32 * rg + r32;
        if (q < nq_valid) {
            bf16_t* orow = Og + (size_t)q * D;
#pragma unroll
            for (int d = 0; d < 4; ++d)
#pragma unroll
                for (int g4 = 0; g4 < 4; ++g4) { const int dd = 32 * d + 8 * g4 + 4 * hi; const f32x4 gv = *(const f32x4*)(gd + dd);
                    u32x2 o; o.x = pk2(O[d][4 * g4] * rstd * gv[0], O[d][4 * g4 + 1] * rstd * gv[1]); o.y = pk2(O[d][4 * g4 + 2] * rstd * gv[2], O[d][4 * g4 + 3] * rstd * gv[3]);
                    *(u32x2*)(orow + dd) = o; }
        }
    }
}

constexpr int ML_BUFB = 40960, ML_Q = 0, ML_K = 8192, ML_KT = 16384, ML_V = 24576;
constexpr int ML_C = 81920, ML_A = 98304, ML_G = 106496, ML_B = 114688, ML_MP = 122880, ML_N = 123136, ML_SS = 123392;
__device__ __forceinline__ void mlstm_unit(ldsp lds, const bf16_t* Pb  , const float* gates  , int h, int nch, int ntok,
                                           const float* C0, const float* n0, const float* m0, bf16_t* Hb  , const float* gm  ,
                                           float* Cout, float* nout, float* mout) {
    int tid = threadIdx.x; asm volatile("" : "+v"(tid));
    const int lane = tid & 63, w = __builtin_amdgcn_readfirstlane(tid >> 6), r32 = lane & 31, hi = lane >> 5;
    const int T = nch * 64;
    LAS float* la = (LAS float*)(lds + ML_A); LAS float* lg = (LAS float*)(lds + ML_G); LAS float* lb = (LAS float*)(lds + ML_B);
    LAS float* lmp = (LAS float*)(lds + ML_MP); LAS float* ln = (LAS float*)(lds + ML_N); LAS float* lss = (LAS float*)(lds + ML_SS);
    for (int t = tid; t < T; t += NTHR) { const bool ok = (t & 63) < ntok; const int rowt = (t >> 6) * 64 + (t & 63);
        la[t] = ok ? gates[(size_t)rowt * 8 + h] : -1e30f; lb[t] = ok ? gates[(size_t)rowt * 8 + 4 + h] : 0.f; }
    if (tid < 64) *(LAS bf16_t*)(lds + ML_N + tid * 2) = (bf16_t)f2bf(n0 ? n0[tid] : 0.f);
    __syncthreads();
    if (w == 0) {
        float mcur = m0 ? m0[0] : 0.f;
        for (int c = 0; c < nch; ++c) {
            float b = lb[64 * c + lane];
#pragma unroll
            for (int o = 1; o < 64; o <<= 1) { const float t = __shfl_up(b, o); if (lane >= o) b += t; }
            const float av = la[64 * c + lane] - b;
            float cm = av;
#pragma unroll
            for (int o = 1; o < 64; o <<= 1) { const float t = __shfl_up(cm, o); if (lane >= o) cm = fmaxf(cm, t); }
            const float g = fmaxf(mcur, cm);
            la[64 * c + lane] = av; lg[64 * c + lane] = g; lb[64 * c + lane] = b;
            if (lane == 0) lmp[c] = mcur;
            mcur = __shfl(b + g, 63);
        }
        if (lane == 0) { lmp[nch] = mcur; mout[0] = mcur; }
    }
    const int vb = w >> 1, db = w & 1, tb = w & 1;
    f32x16 Cacc;
    float nreg = n0 ? n0[32 * db + r32] : 0.f;
#pragma unroll
    for (int r = 0; r < 16; ++r) { const int dv = 32 * vb + crow(r, hi), dk = 32 * db + r32; Cacc[r] = C0 ? C0[dv * 64 + dk] : 0.f; }
#pragma unroll
    for (int r = 0; r < 16; ++r) { const int dv = 32 * vb + crow(r, hi), dk = 32 * db + r32; *(LAS bf16_t*)(lds + ML_C + rimg(dv, dk >> 3, 128) + (dk & 7) * 2) = (bf16_t)f2bf(Cacc[r]); }
    const int st = tid >> 3, sc8 = tid & 7, sv0 = tid >> 4, sc16 = tid & 15;
    u32x4 qr, kr, v0r, v1r;
    {
        const bool ok = st < ntok; const bool ok0 = sv0 < ntok, ok1 = sv0 + 32 < ntok; const u32x4 z = {0u, 0u, 0u, 0u};
        qr = ok ? *(const u32x4*)(Pb + (size_t)st * NPROJ + h * 64 + sc8 * 8) : z; kr = ok ? *(const u32x4*)(Pb + (size_t)st * NPROJ + 256 + h * 64 + sc8 * 8) : z;
        v0r = ok0 ? *(const u32x4*)(Pb + (size_t)sv0 * NPROJ + 512 + h * 128 + sc16 * 8) : z; v1r = ok1 ? *(const u32x4*)(Pb + (size_t)(sv0 + 32) * NPROJ + 512 + h * 128 + sc16 * 8) : z;
    }
    __syncthreads();
    const int vlane = ((lane >> 4) & 1) * 32 + (lane & 3) * 8 + (4 * hi + ((lane & 15) >> 2)) * 64;
    for (int c = 0; c < nch; ++c) {
        const ldsp buf = lds + (c & 1) * ML_BUFB;
        {
            const float g63 = lg[64 * c + 63];
            const float wr = __expf(la[64 * c + st] - g63);
            *(LAS u32x4*)(buf + ML_Q + rimg(st, sc8, 64)) = qr; *(LAS u32x4*)(buf + ML_K + rimg(st, sc8, 64)) = kr;
            u32x4 ks; ks.x = pk2(bflo(kr.x) * wr, bfhi(kr.x) * wr); ks.y = pk2(bflo(kr.y) * wr, bfhi(kr.y) * wr); ks.z = pk2(bflo(kr.z) * wr, bfhi(kr.z) * wr); ks.w = pk2(bflo(kr.w) * wr, bfhi(kr.w) * wr);
            *(LAS u32x4*)(buf + ML_KT + timg(st, sc8)) = ks;
            *(LAS u32x4*)(buf + ML_V + timg(sv0, sc16)) = v0r; *(LAS u32x4*)(buf + ML_V + timg(sv0 + 32, sc16)) = v1r;
        }
        __syncthreads();
        const int t = 32 * tb + r32;
        if (c + 1 < nch) {
            const bf16_t* Pn = Pb + (size_t)(64 * (c + 1)) * NPROJ;
            qr = *(const u32x4*)(Pn + (size_t)st * NPROJ + h * 64 + sc8 * 8); kr = *(const u32x4*)(Pn + (size_t)st * NPROJ + 256 + h * 64 + sc8 * 8);
            v0r = *(const u32x4*)(Pn + (size_t)sv0 * NPROJ + 512 + h * 128 + sc16 * 8); v1r = *(const u32x4*)(Pn + (size_t)(sv0 + 32) * NPROJ + 512 + h * 128 + sc16 * 8);
        }
        u32x2 ogr[4];
#pragma unroll
        for (int g4 = 0; g4 < 4; ++g4) ogr[g4] = *(const u32x2*)(Pb + (size_t)(64 * c + ((t & 63) < ntok ? t : 0)) * NPROJ + 1024 + h * 128 + 32 * vb + 8 * g4 + 4 * hi);
        const float gt = lg[64 * c + t], bt = lb[64 * c + t], mprev = lmp[c];
        f32x16 s0, s1, inter, nqa;
#pragma unroll
        for (int r = 0; r < 16; ++r) { s0[r] = 0.f; s1[r] = 0.f; inter[r] = 0.f; nqa[r] = 0.f; }
#pragma unroll
        for (int stp = 0; stp < 4; ++stp) {
            const int c8 = 2 * stp + hi;
            const bf16x8 qf = lds_frag(buf + ML_Q + rimg(t, c8, 64));
            const bf16x8 k0 = lds_frag(buf + ML_K + rimg(r32, c8, 64)), k1 = lds_frag(buf + ML_K + rimg(32 + r32, c8, 64));
            const bf16x8 cf = lds_frag(lds + ML_C + rimg(32 * vb + r32, c8, 128));
            s0 = __builtin_amdgcn_mfma_f32_32x32x16_bf16(k0, qf, s0, 0, 0, 0);
            s1 = __builtin_amdgcn_mfma_f32_32x32x16_bf16(k1, qf, s1, 0, 0, 0);
            inter = __builtin_amdgcn_mfma_f32_32x32x16_bf16(cf, qf, inter, 0, 0, 0);
            nqa = __builtin_amdgcn_mfma_f32_32x32x16_bf16(lds_frag(lds + ML_N + c8 * 16), qf, nqa, 0, 0, 0);
        }
        float dsum = 0.f;
#pragma unroll
        for (int r = 0; r < 16; ++r) {
            const int sA = crow(r, hi), sB = 32 + sA;
            const float wA = (sA <= t) ? __expf(la[64 * c + sA] - gt) : 0.f, wB = (sB <= t) ? __expf(la[64 * c + sB] - gt) : 0.f;
            s0[r] *= wA; s1[r] *= wB; dsum += s0[r] + s1[r];
        }
        dsum += __shfl_xor(dsum, 32);
        f32x16 intra;
#pragma unroll
        for (int r = 0; r < 16; ++r) intra[r] = 0.f;
        {
            const bf16x8 pf0 = pack8(s0, 0), pf1 = pack8(s0, 1), pf2 = pack8(s1, 0), pf3 = pack8(s1, 1);
            const ldsp vq = buf + ML_V + vlane + vb * 4096;
            intra = __builtin_amdgcn_mfma_f32_32x32x16_bf16(vtr2(vq), pf0, intra, 0, 0, 0);
            intra = __builtin_amdgcn_mfma_f32_32x32x16_bf16(vtr2(vq + 1024), pf1, intra, 0, 0, 0);
            intra = __builtin_amdgcn_mfma_f32_32x32x16_bf16(vtr2(vq + 2048), pf2, intra, 0, 0, 0);
            intra = __builtin_amdgcn_mfma_f32_32x32x16_bf16(vtr2(vq + 3072), pf3, intra, 0, 0, 0);
        }
        const float nq = nqa[0];
        const float winter = __expf(mprev - gt);
        float den = dsum + winter * nq;
        den = fmaxf(fabsf(den), __expf(-(bt + gt)));
        const float rden = 1.0f / den;
        float ssq = 0.f;
#pragma unroll
        for (int r = 0; r < 16; ++r) { const float hv = (intra[r] + winter * inter[r]) * rden; intra[r] = hv; ssq += hv * hv; }
        ssq += __shfl_xor(ssq, 32);
        if (hi == 0) lss[vb * 64 + t] = ssq;
        __syncthreads();
        {
            const float tot = lss[t] + lss[64 + t] + lss[128 + t] + lss[192 + t];
            const float rstd = __builtin_amdgcn_rsqf(tot * (1.0f / 128.0f) + EPS);
            if ((t & 63) < ntok) {
                const size_t rowo = (size_t)(64 * c + t);
                bf16_t* orow = Hb + rowo * D;
#pragma unroll
                for (int g4 = 0; g4 < 4; ++g4) { const int dd = 32 * vb + 8 * g4 + 4 * hi; const f32x4 gv = *(const f32x4*)(gm + dd); const u32x2 ov = ogr[g4];
                    u32x2 o; o.x = pk2(intra[4 * g4] * rstd * gv[0] * bflo(ov.x), intra[4 * g4 + 1] * rstd * gv[1] * bfhi(ov.x));
                    o.y = pk2(intra[4 * g4 + 2] * rstd * gv[2] * bflo(ov.y), intra[4 * g4 + 3] * rstd * gv[3] * bfhi(ov.y));
                    *(u32x2*)(orow + dd) = o; }
            }
        }
        {
            const float wstate = __expf(mprev - lg[64 * c + 63]);
#pragma unroll
            for (int r = 0; r < 16; ++r) Cacc[r] *= wstate;
            const ldsp vq = buf + ML_V + vlane + vb * 4096; const ldsp kq = buf + ML_KT + vlane + db * 4096;
            f32x16 nsum;
#pragma unroll
            for (int r = 0; r < 16; ++r) nsum[r] = 0.f;
            const bf16x8 ones = {0x3f80, 0x3f80, 0x3f80, 0x3f80, 0x3f80, 0x3f80, 0x3f80, 0x3f80};
#pragma unroll
            for (int ks = 0; ks < 4; ++ks) { const bf16x8 kf = vtr2(kq + ks * 1024); Cacc = __builtin_amdgcn_mfma_f32_32x32x16_bf16(vtr2(vq + ks * 1024), kf, Cacc, 0, 0, 0);
                nsum = __builtin_amdgcn_mfma_f32_32x32x16_bf16(ones, kf, nsum, 0, 0, 0); }
            nreg = nreg * wstate + nsum[0];
#pragma unroll
            for (int r = 0; r < 16; ++r) { const int dv = 32 * vb + crow(r, hi), dk = 32 * db + r32; *(LAS bf16_t*)(lds + ML_C + rimg(dv, dk >> 3, 128) + (dk & 7) * 2) = (bf16_t)f2bf(Cacc[r]); }
            if (vb == 0 && hi == 0) *(LAS bf16_t*)(lds + ML_N + (32 * db + r32) * 2) = (bf16_t)f2bf(nreg);
        }
    }
    __syncthreads();
#pragma unroll
    for (int r = 0; r < 16; ++r) { const int dv = 32 * vb + crow(r, hi), dk = 32 * db + r32; Cout[dv * 64 + dk] = Cacc[r]; }
    if (vb == 0 && hi == 0) nout[32 * db + r32] = nreg;
}

constexpr int U_ML = 128, U_AS = 32, U_AP = 2048, U_MS = 32, NUNITS = U_ML + U_AS + U_AP + U_MS;
__device__ __forceinline__ void mixer_phase(const Args& a, ldsp lds, int rep) {
    unsigned char* ws = a.ws;
    unsigned* ctr = (unsigned*)(ws + WS_CTL) + rep;
    const float lam = ((const float*)(ws + WS_CTL))[64];
    const bf16_t* P = (const bf16_t*)(ws + WS_P); bf16_t* H = (bf16_t*)(ws + WS_H);
    const float* gates = (const float*)(ws + WS_GATES);
    LAS unsigned* su = (LAS unsigned*)(lds + 131072);
    float* out = a.out;
    const int w = __builtin_amdgcn_readfirstlane(threadIdx.x >> 6);
    for (;;) {
        __syncthreads();
        if (threadIdx.x == 0) su[0] = atomicAdd(ctr, 1u);
        __syncthreads();
        int u = __builtin_amdgcn_readfirstlane((int)su[0]);
        if (u >= NUNITS) break;
        const bool is_ml = (u < U_ML) || (u >= U_ML + U_AS + U_AP);
        if (is_ml) {
            const bool samp = u >= U_ML; if (samp) u -= U_ML + U_AS + U_AP;
            const int b = u >> 2, h = u & 3;
            const size_t row0 = samp ? (size_t)(MP + 16 * b) : (size_t)b * SEQ;
            mlstm_unit(lds, P + row0 * NPROJ, gates + row0 * 8, h, samp ? 1 : 32, samp ? 16 : 64,
                       samp ? a.in[4] + (size_t)u * 8192 : nullptr, samp ? a.in[5] + u * 64 : nullptr, samp ? a.in[6] + u : nullptr,
                       H + row0 * D + h * 128, a.in[17] + h * 128,
                       out + (samp ? O_CS : O_CP) + (size_t)u * 8192, out + (samp ? O_NS : O_NP) + u * 64, out + (samp ? O_MS : O_MPR) + u);
        } else {
            u -= U_ML;
            const bool samp = u < U_AS; if (!samp) u -= U_AS;
            const int qb = samp ? 0 : 15 - (u >> 7), bh = samp ? u : (u & 127), b = bh >> 2, h = bh & 3;
            const size_t qrow0 = samp ? (size_t)(MP + 16 * b) : (size_t)b * SEQ + 128 * qb;
            const bf16_t* Kg = samp ? (const bf16_t*)(ws + WS_SK) + (size_t)b * 1088 * 512 + h * 128 : P + (size_t)b * SEQ * NPROJ + 2048 + h * 128;
            const bf16_t* Vg = samp ? (const bf16_t*)(ws + WS_SV) + (size_t)b * 1088 * 512 + h * 128 : P + (size_t)b * SEQ * NPROJ + 2560 + h * 128;
            const int lim = samp ? ((w >> 1) == 0 ? 16 : -1) : 2 * qb + (w >> 2);
            attn_unit(lds, P + qrow0 * NPROJ + 1536 + h * 128, NPROJ, samp ? 16 : 128, Kg, Vg, samp ? 512 : NPROJ, samp ? 17 : 2 * qb + 2, lim, samp ? 16 : 64,
                      H + qrow0 * D + 512 + h * 128, a.in[18] + h * 128, lam);
        }
    }
}

template <int MODE, int SB  , int NB  >
__device__ __forceinline__ void mini_gemm(ldsp lds, const bf16_t* A, const bf16_t* Bt, int K, int ntn, bf16_t* O, const Args& a) {
    int tid = threadIdx.x; asm volatile("" : "+v"(tid));
    const int lane = tid & 63, w = __builtin_amdgcn_readfirstlane(tid >> 6), r32 = lane & 31, hi = lane >> 5;
    LAS float* red = (LAS float*)lds;
    unsigned char* ws = a.ws;
    for (int task = blockIdx.x; task < 4 * ntn; task += gridDim.x) {
        const int mt = task / ntn, nt = task % ntn;
        const int wrow0 = (MODE == 1) ? (256 * (nt >> 2) + 32 * (nt & 3)) : 32 * nt;
        const bf16_t* ap = A + (size_t)(32 * mt + r32) * K + (size_t)w * (SB * NB * 16) + 8 * hi;
        const bf16_t* bp = Bt + (size_t)(wrow0 + r32) * K + (size_t)w * (SB * NB * 16) + 8 * hi;
        f32x16 acc0, acc1;
#pragma unroll
        for (int r = 0; r < 16; ++r) { acc0[r] = 0.f; acc1[r] = 0.f; }
#pragma unroll 1
        for (int nb = 0; nb < NB; ++nb) {
            bf16x8 af[SB], b0[SB], b1[SB];
#pragma unroll
            for (int i = 0; i < SB; ++i) { af[i] = *(const bf16x8*)(ap + (nb * SB + i) * 16); b0[i] = *(const bf16x8*)(bp + (nb * SB + i) * 16);
                if (MODE == 1) b1[i] = *(const bf16x8*)(bp + (size_t)128 * K + (nb * SB + i) * 16); }
#pragma unroll
            for (int i = 0; i < SB; ++i) { acc0 = __builtin_amdgcn_mfma_f32_32x32x16_bf16(b0[i], af[i], acc0, 0, 0, 0);
                if (MODE == 1) acc1 = __builtin_amdgcn_mfma_f32_32x32x16_bf16(b1[i], af[i], acc1, 0, 0, 0); }
        }
#pragma unroll
        for (int r = 0; r < 16; ++r) { red[((w * 2 + 0) * 16 + r) * 64 + lane] = acc0[r]; if (MODE == 1) red[((w * 2 + 1) * 16 + r) * 64 + lane] = acc1[r]; }
        __syncthreads();
        {
            LAS float* fin = (LAS float*)(lds + 65536);
#pragma unroll
            for (int rr = 0; rr < 2; ++rr) { const int r = 2 * w + rr; float s0 = 0.f, s1 = 0.f;
#pragma unroll
                for (int k = 0; k < 8; ++k) { s0 += red[((k * 2 + 0) * 16 + r) * 64 + lane]; if (MODE == 1) s1 += red[((k * 2 + 1) * 16 + r) * 64 + lane]; }
                fin[r * 64 + lane] = s0; if (MODE == 1) fin[(16 + r) * 64 + lane] = s1; }
        }
        __syncthreads();
        if (w == 0) {
            const LAS float* fin = (const LAS float*)(lds + 65536);
#pragma unroll
            for (int r = 0; r < 16; ++r) { acc0[r] = fin[r * 64 + lane]; acc1[r] = (MODE == 1) ? fin[(16 + r) * 64 + lane] : 0.f; }
            const int srow = 32 * mt + r32;
            if (MODE == 0) {
                bf16_t* o = O + (size_t)srow * D + 32 * nt;
#pragma unroll
                for (int g = 0; g < 4; ++g) { u32x2 v; v.x = pk2(acc0[4 * g], acc0[4 * g + 1]); v.y = pk2(acc0[4 * g + 2], acc0[4 * g + 3]); *(u32x2*)(o + 8 * g + 4 * hi) = v; }
            } else if (MODE == 1) {
                bf16_t* o = O + (size_t)srow * FF + 32 * nt;
#pragma unroll
                for (int r = 0; r < 16; ++r) acc0[r] = acc0[r] * pg8::fast_sigmoid(acc0[r]) * acc1[r];
#pragma unroll
                for (int g = 0; g < 4; ++g) { u32x2 v; v.x = pk2(acc0[4 * g], acc0[4 * g + 1]); v.y = pk2(acc0[4 * g + 2], acc0[4 * g + 3]); *(u32x2*)(o + 8 * g + 4 * hi) = v; }
            } else {
                const int col0 = 32 * nt, pn = col0 >> 8;
                const int type = (pn == 0) ? 0 : (pn == 1) ? 1 : (pn < 4) ? 2 : (pn < 6) ? 3 : (pn < 8) ? 4 : (pn < 10) ? 5 : 6;
                if (type == 1) {
#pragma unroll
                    for (int r = 0; r < 16; ++r) acc0[r] *= 0.125f;
                } else if (type == 3) {
#pragma unroll
                    for (int r = 0; r < 16; ++r) acc0[r] = pg8::fast_sigmoid(acc0[r]);
                } else if ((type == 4 || type == 5) && (col0 & 63) == 0) {
                    const float* t = (const float*)(ws + WS_ROPE) + (1024 + (srow & 15)) * 16 + 4 * hi;
                    const f32x4 cs = *(const f32x4*)t, sn = *(const f32x4*)(t + 8);
#pragma unroll
                    for (int j = 0; j < 4; ++j) { const float x1 = acc0[j], x2 = acc0[4 + j]; acc0[j] = x1 * cs[j] - x2 * sn[j]; acc0[4 + j] = x2 * cs[j] + x1 * sn[j]; }
                }
                if (type >= 5) {
                    const int c512 = col0 - (type == 5 ? 2048 : 2560);
                    float* o = a.out + (type == 5 ? O_KS : O_VS) + (size_t)srow * 512 + c512;
#pragma unroll
                    for (int g = 0; g < 4; ++g) *(f32x4*)(o + 8 * g + 4 * hi) = (f32x4){acc0[4 * g], acc0[4 * g + 1], acc0[4 * g + 2], acc0[4 * g + 3]};
                }
                if (type == 4) {
#pragma unroll
                    for (int r = 0; r < 16; ++r) acc0[r] *= (0.125f * 1.4426950408889634f);
                }
                bf16_t* o = O + (size_t)srow * NPROJ + col0;
                bf16_t* o2 = (bf16_t*)(ws + (type == 5 ? WS_SK : WS_SV)) + ((size_t)((srow >> 4) * 1088 + 1024 + (srow & 15)) * 512 + (col0 - (type == 5 ? 2048 : 2560)));
#pragma unroll
                for (int g = 0; g < 4; ++g) { u32x2 v; v.x = pk2(acc0[4 * g], acc0[4 * g + 1]); v.y = pk2(acc0[4 * g + 2], acc0[4 * g + 3]); *(u32x2*)(o + 8 * g + 4 * hi) = v;
                    if (type >= 5) *(u32x2*)(o2 + 8 * g + 4 * hi) = v; }
            }
        }
        __syncthreads();
    }
}

#define XB_TMO      128
#define XB_XCNT(j)  (256  + 64 * (j))
#define XB_XSUB(j)  (1280 + 64 * (j))
#define XB_XGEN(j)  (2304 + 64 * (j))
#define XB_TOP      3328
#define XB_TOPGEN   3392
#define XCD_BAR_WORDS 3456
#define XB_SPIN_CAP (1u << 22)

__device__ __forceinline__ unsigned xb_ld(unsigned* p)              { return __hip_atomic_load(p, __ATOMIC_RELAXED, __HIP_MEMORY_SCOPE_AGENT); }
__device__ __forceinline__ unsigned xb_add(unsigned* p, unsigned v) { return __hip_atomic_fetch_add(p, v, __ATOMIC_RELAXED, __HIP_MEMORY_SCOPE_AGENT); }
__device__ __forceinline__ unsigned xb_xcc_id() { return (unsigned)__builtin_amdgcn_s_getreg((3 << 11) | 20) & 0xFu; }
#define XB_SPIN(cond, bar) do { unsigned _sp = 0; while (cond) { __builtin_amdgcn_s_sleep(1); \
    if ((++_sp & 255u) == 0u) { if (xb_ld(&(bar)[XB_TMO])) break; if (_sp > XB_SPIN_CAP) { atomicAdd(&(bar)[XB_TMO], 1u); break; } } } } while (0)

struct XcdBarrier {
    unsigned* bar; unsigned x;
    volatile LAS unsigned* st;
};

__device__ __forceinline__ XcdBarrier xcd_barrier_post(unsigned* bar, volatile LAS unsigned* st) {
    XcdBarrier b; b.bar = bar; b.x = xb_xcc_id(); b.st = st;
    if (threadIdx.x == 0) (void)xb_add(&bar[XB_XCNT(b.x)], 1u);
    return b;
}
__device__ __forceinline__ void xcd_barrier_complete(unsigned* bar, unsigned x, unsigned& nloc, unsigned& nx) {
    const unsigned G = gridDim.x * gridDim.y * gridDim.z;
    unsigned sum, cnt, mine, sp = 0u;
    for (;;) {
        sum = 0u; cnt = 0u; mine = 0u;
#pragma unroll
        for (unsigned j = 0; j < 16; ++j) { const unsigned c = xb_ld(&bar[XB_XCNT(j)]); sum += c; cnt += (c > 0u) ? 1u : 0u; mine = (j == x) ? c : mine; }
        if (sum == G) break;
        __builtin_amdgcn_s_sleep(1);
        if ((++sp & 255u) == 0u) { if (xb_ld(&bar[XB_TMO])) break; if (sp > XB_SPIN_CAP) { atomicAdd(&bar[XB_TMO], 1u); break; } }
    }
    nloc = mine > 0u ? mine : 1u; nx = cnt > 0u ? cnt : 1u;
}

__device__ __forceinline__ void xcd_barrier(const XcdBarrier& b) {
    asm volatile("s_waitcnt vmcnt(0)" ::: "memory");
    __syncthreads();
    if (threadIdx.x == 0) {
        unsigned* bar = b.bar;
        __builtin_amdgcn_s_waitcnt(0);
        unsigned nloc = b.st[0], nx = b.st[1];
        if (nloc == 0u) { xcd_barrier_complete(bar, b.x, nloc, nx); b.st[0] = nloc; b.st[1] = nx; }
        const unsigned old = xb_add(&bar[XB_XSUB(b.x)], 1u);
        const unsigned gen = old / nloc;
        if (old + 1u == (gen + 1u) * nloc) {
            __builtin_amdgcn_fence(__ATOMIC_RELEASE, "agent");
            asm volatile("s_waitcnt vmcnt(0)" ::: "memory");
            const unsigned og = xb_add(&bar[XB_TOP], 1u);
            const unsigned tg = og / nx;
            if (og + 1u == (tg + 1u) * nx) xb_add(&bar[XB_TOPGEN], 1u);
            else XB_SPIN(xb_ld(&bar[XB_TOPGEN]) == tg, bar);
            __builtin_amdgcn_fence(__ATOMIC_ACQUIRE, "agent");
            xb_add(&bar[XB_XGEN(b.x)], 1u);
            asm volatile("s_waitcnt vmcnt(0)" ::: "memory");
        } else {
            XB_SPIN(xb_ld(&bar[XB_XGEN(b.x)]) == gen, bar);
            __builtin_amdgcn_fence(__ATOMIC_ACQUIRE, "agent");
            asm volatile("s_waitcnt vmcnt(0)" ::: "memory");
        }
    }
    __syncthreads();
}

constexpr int NPHASE = 12;
#ifndef REP_MASK
#define REP_MASK 0
#endif
template <bool COOP>
__global__ void __launch_bounds__(NTHR, 2) mega(Args a) {
    extern __shared__ __attribute__((aligned(16))) unsigned char lds_raw[];
    ldsp lds = (ldsp)lds_raw;
    unsigned char* ws = a.ws;
    const int lo = a.ph_lo, hi = a.ph_hi, G = gridDim.x, bx = blockIdx.x;
#define IN(k) (lo <= (k) && (k) < hi)
    XcdBarrier bar; bar.bar = (unsigned*)(ws + WS_CTL) + 4096; bar.x = 0; bar.st = nullptr;
    if (COOP) {
        volatile LAS unsigned* misc = (volatile LAS unsigned*)(lds + 131072 + 64);
        if (threadIdx.x < 2) misc[threadIdx.x] = 0u;
        __syncthreads();
        bar = xcd_barrier_post((unsigned*)(ws + WS_CTL) + 4096, misc);
    }
#define SEAM(k) do { if (COOP) { if (IN(k) && IN((k) + 1)) { if ((k) == 0) cg::this_grid().sync(); else xcd_barrier(bar); } } } while (0)
    bf16_t* H = (bf16_t*)(ws + WS_H); bf16_t* F = (bf16_t*)(ws + WS_F); bf16_t* P = (bf16_t*)(ws + WS_P);
    float* X = a.out + O_Y;
    if (IN(0)) { for (int rep = 0; rep < 1 + ((REP_MASK >> 0) & 1); ++rep) { if (rep) { if (COOP) xcd_barrier(bar); } p0_prologue(a, lds); } } SEAM(0);
    if (IN(1)) { for (int rep = 0; rep < 1 + ((REP_MASK >> 1) & 1); ++rep) { if (rep) { if (COOP) xcd_barrier(bar); } row_phase<false, true, false>(a, lds, a.in[0], a.in[1], nullptr, 0, 0.f, 0, 0, 0, 1); } } SEAM(1);
    if (IN(2)) { for (int rep = 0; rep < 1 + ((REP_MASK >> 2) & 1); ++rep) { if (rep) { if (COOP) xcd_barrier(bar); } pg8::Gemm g{H, (const bf16_t*)(ws + WS_W1I), MP, 2 * FF, D}; pg8::StaticOrder S; S.init(MP, 2 * FF, G, bx); pg8::EpiSwiglu E{P, FF, 1.0f};
        pg8::gemm_phase<pg8::EpiSwiglu, pg8::StaticOrder, true, true>(lds, g, S, E);
        mini_gemm<1, 8, 1>(lds, H + (size_t)MP * D, (const bf16_t*)(ws + WS_W1I), D, FF / 32, P + (size_t)MP * FF, a); } } SEAM(2);
    if (IN(3)) { for (int rep = 0; rep < 1 + ((REP_MASK >> 3) & 1); ++rep) { if (rep) { if (COOP) xcd_barrier(bar); } pg8::Gemm g{P, (const bf16_t*)(ws + WS_W1O), MP, D, FF}; pg8::StaticOrder S; S.init(MP, D, G, bx); pg8::EpiPlain E{F, D, 1.0f};
        pg8::gemm_phase<pg8::EpiPlain, pg8::StaticOrder, true, true>(lds, g, S, E);
        mini_gemm<0, 11, 2>(lds, P + (size_t)MP * FF, (const bf16_t*)(ws + WS_W1O), FF, D / 32, F + (size_t)MP * D, a); } } SEAM(3);
    if (IN(4)) { for (int rep = 0; rep < 1 + ((REP_MASK >> 4) & 1); ++rep) { if (rep) { if (COOP) xcd_barrier(bar); } row_phase<true, true, true, false, false, true>(a, lds, a.in[0], a.in[1], X, 2, 0.5f, 1, 2, 3, 4); } } SEAM(4);
    if (IN(5)) { for (int rep = 0; rep < 1 + ((REP_MASK >> 5) & 1); ++rep) { if (rep) { if (COOP) xcd_barrier(bar); } pg8::Gemm g{H, (const bf16_t*)(ws + WS_WIN), MP, NPROJ, D}; pg8::StaticOrder S; S.init(MP, NPROJ, G, bx);
        pg8::EpiProj E{P, (bf16_t*)(ws + WS_SK), (bf16_t*)(ws + WS_SV), a.out + O_KP, a.out + O_VP, a.out + O_KS, a.out + O_VS, (const float*)(ws + WS_ROPE)};
        pg8::gemm_phase<pg8::EpiProj, pg8::StaticOrder, true, true>(lds, g, S, E);
        mini_gemm<2, 8, 1>(lds, H + (size_t)MP * D, (const bf16_t*)(ws + WS_WIN), D, NPROJ / 32, P + (size_t)MP * NPROJ, a); } } SEAM(5);
    if (IN(6)) { for (int rep = 0; rep < 1 + ((REP_MASK >> 6) & 1); ++rep) { if (rep) { if (COOP) xcd_barrier(bar); } mixer_phase(a, lds, rep); } } SEAM(6);
    if (IN(7)) { for (int rep = 0; rep < 1 + ((REP_MASK >> 7) & 1); ++rep) { if (rep) { if (COOP) xcd_barrier(bar); } pg8::Gemm g{H, (const bf16_t*)(ws + WS_WO), MP, D, D}; pg8::StaticOrder S; S.init(MP, D, G, bx); pg8::EpiPlain E{F, D, 1.0f};
        pg8::gemm_phase<pg8::EpiPlain, pg8::StaticOrder, true, true>(lds, g, S, E);
        mini_gemm<0, 8, 1>(lds, H + (size_t)MP * D, (const bf16_t*)(ws + WS_WO), D, D / 32, F + (size_t)MP * D, a); } } SEAM(7);
    if (IN(8)) { for (int rep = 0; rep < 1 + ((REP_MASK >> 8) & 1); ++rep) { if (rep) { if (COOP) xcd_barrier(bar); } row_phase<true, true, false, true, true, true>(a, lds, X, X + (size_t)MP * D, X, 5, 1.0f, 3, 4, 6, 7); } } SEAM(8);
    if (IN(9)) { for (int rep = 0; rep < 1 + ((REP_MASK >> 9) & 1); ++rep) { if (rep) { if (COOP) xcd_barrier(bar); } pg8::Gemm g{H, (const bf16_t*)(ws + WS_W2I8), MP, 2 * FF, D / 2}; pg8::StaticOrder S; S.init(MP, 2 * FF, G, bx); pg8::EpiSwigluF8 E{(unsigned char*)P, FF, 1.0f / (H8_SCALE * W8_SCALE), A8_SCALE};
        pg8::gemm_phase<pg8::EpiSwigluF8, pg8::StaticOrder, true, true, true>(lds, g, S, E);
        mini_gemm<1, 8, 1>(lds, H + (size_t)MP * D, (const bf16_t*)(ws + WS_W2I), D, FF / 32, P + (size_t)MP * FF, a); } } SEAM(9);
    if (IN(10)) { for (int rep = 0; rep < 1 + ((REP_MASK >> 10) & 1); ++rep) { if (rep) { if (COOP) xcd_barrier(bar); } pg8::Gemm g{P, (const bf16_t*)(ws + WS_W2O8), MP, D, FF / 2}; pg8::StaticOrder S; S.init(MP, D, G, bx); pg8::EpiPlain E{F, D, 1.0f / (A8_SCALE * W8_SCALE)};
        pg8::gemm_phase<pg8::EpiPlain, pg8::StaticOrder, true, true, true>(lds, g, S, E);
        mini_gemm<0, 11, 2>(lds, P + (size_t)MP * FF, (const bf16_t*)(ws + WS_W2O), FF, D / 32, F + (size_t)MP * D, a); } } SEAM(10);
    if (IN(11)) { for (int rep = 0; rep < 1 + ((REP_MASK >> 11) & 1); ++rep) { if (rep) { if (COOP) xcd_barrier(bar); } row_phase<true, false, false, false, true, false>(a, lds, X, X + (size_t)MP * D, X, 8, 0.5f, 5, 0, 0, 0); } }
#undef IN
#undef SEAM
}

#ifndef MK_LAUNCHES
#define MK_LAUNCHES 1
#endif
extern "C" void kernel_launch(void* const* d_in, const int* in_sizes, int n_in, void* d_out, int out_size, void* d_ws, size_t ws_size, hipStream_t stream) {
    static int grid = 0;
    if (grid == 0) {
        if (n_in != 23 || (size_t)out_size != O_END || ws_size < WS_END) { fprintf(stderr, "kernel_launch: unexpected shapes (n_in %d, out %d, ws %zu)\n", n_in, out_size, ws_size); grid = -1; return; }
        int dev = 0, cus = 0, per_cu = 0;
        hipGetDevice(&dev); hipDeviceGetAttribute(&cus, hipDeviceAttributeMultiprocessorCount, dev);
        hipFuncSetAttribute((const void*)mega<true>, hipFuncAttributeMaxDynamicSharedMemorySize, LDS_BYTES);
        hipFuncSetAttribute((const void*)mega<false>, hipFuncAttributeMaxDynamicSharedMemorySize, LDS_BYTES);
        hipOccupancyMaxActiveBlocksPerMultiprocessor(&per_cu, (const void*)mega<true>, NTHR, LDS_BYTES);
        if (per_cu < 1) per_cu = 1;
        (void)hipGetLastError();
        grid = cus * per_cu;
    }
    if (grid < 0) return;
    if (hipMemsetAsync(d_ws, 0, 65536, stream) != hipSuccess) { fprintf(stderr, "kernel_launch: memset failed\n"); return; }
    Args a{};
    for (int i = 0; i < 23; ++i) a.in[i] = (const float*)d_in[i];
    a.out = (float*)d_out; a.ws = (unsigned char*)d_ws;
    if (MK_LAUNCHES == 1) {
        a.ph_lo = 0; a.ph_hi = NPHASE;
        void* args[] = {&a};
        hipError_t e = hipLaunchCooperativeKernel((const void*)mega<true>, dim3(grid), dim3(NTHR), args, LDS_BYTES, stream);
        if (e != hipSuccess) fprintf(stderr, "cooperative launch failed: %s (grid %d)\n", hipGetErrorString(e), grid);
    } else {
        for (int p = 0; p < NPHASE; ++p) { a.ph_lo = p; a.ph_hi = p + 1; hipLaunchKernelGGL(mega<false>, dim3(grid), dim3(NTHR), LDS_BYTES, stream, a); }
    }
}
```

```cpp
#include <hip/hip_runtime.h>
#include <hip/hip_cooperative_groups.h>
#include <cstdio>
#include <cstdint>
#include <cmath>
namespace pg8 {
#define PG8_LAS __attribute__((address_space(3)))
typedef unsigned short bf16_t;
typedef short bf16x8 __attribute__((ext_vector_type(8)));
typedef float f32x4 __attribute__((ext_vector_type(4)));
typedef unsigned u32x4 __attribute__((ext_vector_type(4)));
typedef int v8i32 __attribute__((ext_vector_type(8)));
typedef int v4i32 __attribute__((ext_vector_type(4)));
constexpr int BM = 256, BK = 64, HALF = 128, HTB = HALF * BK * 2  , STAGE_BYTES = 8 * HTB, NXCD = 8, WGM = 8;

__host__ __device__ __forceinline__ int lds_byte(int r, int c) { const int st = (r >> 4) * 2 + (c >> 5), rr = r & 15, cc = c & 31, ob = rr * 64 + cc * 2; return st * 1024 + (ob ^ (((ob >> 9) & 1) << 5)); }
__host__ __device__ __forceinline__ void stage_rc(int b, int& R, int& C) { const int st = b / 1024, sb = b % 1024, swz = sb ^ (((sb >> 9) & 1) << 5); R = (st >> 1) * 16 + swz / 64; C = (st & 1) * 32 + (swz % 64) / 2; }
__host__ __device__ __forceinline__ int perm32(int rho) { const int n = rho >> 4, i = rho & 15; return 8 * (i >> 2) + 4 * n + (i & 3); }

struct Unit { int pm, pn; };
struct Gemm { const bf16_t* A; const bf16_t* Bt; int M, N, K; };

struct StaticOrder {
    int nM, nN, nwg, G, c;
    __host__ __device__ void init(int M, int N, int G_, int c_) { nM = M / BM; nN = N / BM; nwg = nM * nN; G = G_; c = c_; }
    __host__ __device__ bool next(int i, Unit& u) const {
        const long L = (long)i * G + c; if (L >= nwg) return false;
        int wgid = (int)L; { const int q = nwg / NXCD, r = nwg % NXCD, xcd = wgid % NXCD, off = wgid / NXCD; wgid = (xcd < r ? xcd * (q + 1) : r * (q + 1) + (xcd - r) * q) + off; }
        const int nig = WGM * nN, gid = wgid / nig, fm = gid * WGM, gsz = (nM - fm) < WGM ? (nM - fm) : WGM;
        u.pm = fm + ((wgid % nig) % gsz); u.pn = (wgid % nig) / gsz; return true;
    }
    __device__ __forceinline__ void a_ready(const Unit&) const {}
    __device__ __forceinline__ void done(const Unit&) const {}
};
__device__ __forceinline__ unsigned cvt_pk_bf16(float lo, float hi) { unsigned r; asm volatile("v_cvt_pk_bf16_f32 %0, %1, %2" : "=v"(r) : "v"(lo), "v"(hi)); return r; }
typedef float f32x2 __attribute__((ext_vector_type(2)));
typedef unsigned u32x4 __attribute__((ext_vector_type(4)));
constexpr int E_MP = 65536, E_MV = 65664;
__device__ __forceinline__ float fast_sigmoid(float x) { return __builtin_amdgcn_rcpf(1.0f + __expf(-x)); }
struct EpiSwiglu {
    static constexpr bool PERM = true, AFTER_DRAIN = false;
    bf16_t* O; int ldo; float sc;
    __device__ __forceinline__ void operator()(const f32x4 (&acc)[2][2][4][2], const Unit& u, int wr, int wc, int fr, int fq) const {
        const int row0 = u.pm * BM + wr * 64 + fr, col0 = u.pn * 128 + wc * 32 + 8 * fq;
#pragma unroll
        for (int ai = 0; ai < 2; ++ai)
#pragma unroll
            for (int m = 0; m < 4; ++m) {
                bf16_t* p = O + (size_t)(row0 + ai * HALF + m * 16) * ldo + col0;
                const f32x4 g0 = acc[ai][0][m][0] * sc, g1 = acc[ai][0][m][1] * sc, u0 = acc[ai][1][m][0] * sc, u1 = acc[ai][1][m][1] * sc;
                f32x4 a0, a1;
#pragma unroll
                for (int j = 0; j < 4; ++j) { a0[j] = g0[j] * fast_sigmoid(g0[j]) * u0[j]; a1[j] = g1[j] * fast_sigmoid(g1[j]) * u1[j]; }
                u32x4 w; w.x = cvt_pk_bf16(a0[0], a0[1]); w.y = cvt_pk_bf16(a0[2], a0[3]); w.z = cvt_pk_bf16(a1[0], a1[1]); w.w = cvt_pk_bf16(a1[2], a1[3]);
                *(u32x4*)p = w;
            }
    }
};
struct EpiSwiglu8 {
    static constexpr bool PERM = false, AFTER_DRAIN = false;
    bf16_t* O; int ldo; float sc;
    __device__ __forceinline__ void operator()(const f32x4 (&acc)[2][2][4][2], const Unit& u, int wr, int wc, int fr, int fq) const {
        typedef unsigned u32x2e __attribute__((ext_vector_type(2)));
        const int row0 = u.pm * BM + wr * 64 + fr, col0 = u.pn * 128 + wc * 32 + 4 * fq;
#pragma unroll
        for (int ai = 0; ai < 2; ++ai)
#pragma unroll
            for (int m = 0; m < 4; ++m) {
                bf16_t* p = O + (size_t)(row0 + ai * HALF + m * 16) * ldo + col0;
#pragma unroll
                for (int n = 0; n < 2; ++n) {
                    const f32x4 g = acc[ai][0][m][n] * sc, up = acc[ai][1][m][n] * sc;
                    f32x4 a0;
#pragma unroll
                    for (int j = 0; j < 4; ++j) a0[j] = g[j] * fast_sigmoid(g[j]) * up[j];
                    u32x2e w; w.x = cvt_pk_bf16(a0[0], a0[1]); w.y = cvt_pk_bf16(a0[2], a0[3]);
                    *(u32x2e*)(p + 16 * n) = w;
                }
            }
    }
};
struct EpiSwigluF8 {
    static constexpr bool PERM = false, AFTER_DRAIN = false;
    unsigned char* O; int ldo; float sc, so;
    __device__ __forceinline__ void operator()(const f32x4 (&acc)[2][2][4][2], const Unit& u, int wr, int wc, int fr, int fq) const {
        const int row0 = u.pm * BM + wr * 64 + fr, col0 = u.pn * 128 + wc * 32 + 4 * fq;
#pragma unroll
        for (int ai = 0; ai < 2; ++ai)
#pragma unroll
            for (int m = 0; m < 4; ++m) {
                unsigned char* p = O + (size_t)(row0 + ai * HALF + m * 16) * ldo + col0;
#pragma unroll
                for (int n = 0; n < 2; ++n) {
                    const f32x4 g = acc[ai][0][m][n] * sc, up = acc[ai][1][m][n] * sc;
                    f32x4 a0;
#pragma unroll
                    for (int j = 0; j < 4; ++j) a0[j] = g[j] * fast_sigmoid(g[j]) * up[j] * so;
                    unsigned q = 0u;
                    q = __builtin_amdgcn_cvt_pk_fp8_f32(a0[0], a0[1], q, false); q = __builtin_amdgcn_cvt_pk_fp8_f32(a0[2], a0[3], q, true);
                    *(unsigned*)(p + 16 * n) = q;
                }
            }
    }
};
struct EpiPlain {
    static constexpr bool PERM = true, AFTER_DRAIN = false;
    bf16_t* O; int ldo; float sc;
    __device__ __forceinline__ void operator()(const f32x4 (&acc)[2][2][4][2], const Unit& u, int wr, int wc, int fr, int fq) const {
        const int row0 = u.pm * BM + wr * 64 + fr, col0 = u.pn * BM + wc * 32 + 8 * fq;
#pragma unroll
        for (int ai = 0; ai < 2; ++ai)
#pragma unroll
            for (int m = 0; m < 4; ++m) {
                bf16_t* p = O + (size_t)(row0 + ai * HALF + m * 16) * ldo + col0;
#pragma unroll
                for (int bj = 0; bj < 2; ++bj) {
                    const f32x4 v0 = acc[ai][bj][m][0] * sc, v1 = acc[ai][bj][m][1] * sc;
                    u32x4 w; w.x = cvt_pk_bf16(v0[0], v0[1]); w.y = cvt_pk_bf16(v0[2], v0[3]); w.z = cvt_pk_bf16(v1[0], v1[1]); w.w = cvt_pk_bf16(v1[2], v1[3]);
                    *(u32x4*)(p + bj * HALF) = w;
                }
            }
    }
};
struct EpiProj {
    static constexpr bool PERM = true, AFTER_DRAIN = false;
    bf16_t* P; bf16_t* SK; bf16_t* SV; float* okp; float* ovp; float* oks; float* ovs; const float* rope;
    __device__ __forceinline__ void operator()(const f32x4 (&acc)[2][2][4][2], const Unit& u, int wr, int wc, int fr, int fq) const {
        const int pn = u.pn;
        const int type = (pn == 0) ? 0 : (pn == 1) ? 1 : (pn < 4) ? 2 : (pn < 6) ? 3 : (pn < 8) ? 4 : (pn < 10) ? 5 : 6;
        const bool rot = (type == 4 || type == 5) && ((wc & 1) == 0);
        f32x4 ncs0 = {1.f, 1.f, 1.f, 1.f}, ncs1 = ncs0, nsn0 = {0.f, 0.f, 0.f, 0.f}, nsn1 = nsn0;
        if (rot) { const float* t = rope + ((u.pm * BM + wr * 64 + fr) & 2047) * 16; ncs0 = *(const f32x4*)t; ncs1 = *(const f32x4*)(t + 4); nsn0 = *(const f32x4*)(t + 8); nsn1 = *(const f32x4*)(t + 12); }
#pragma unroll
        for (int ai = 0; ai < 2; ++ai)
#pragma unroll
            for (int m = 0; m < 4; ++m) {
                const int row = u.pm * BM + ai * HALF + wr * 64 + m * 16 + fr;
                const bool samp = row >= E_MP, valid = row < E_MV;
                const f32x4 cs0 = ncs0, cs1 = ncs1, sn0 = nsn0, sn1 = nsn1;
                if (rot && (ai * 4 + m) < 7) { const int it = ai * 4 + m + 1; const float* t = rope + ((u.pm * BM + (it >> 2) * HALF + wr * 64 + (it & 3) * 16 + fr) & 2047) * 16;
                    ncs0 = *(const f32x4*)t; ncs1 = *(const f32x4*)(t + 4); nsn0 = *(const f32x4*)(t + 8); nsn1 = *(const f32x4*)(t + 12); }
#pragma unroll
                for (int bj = 0; bj < 2; ++bj) {
                    f32x4 v0 = acc[ai][bj][m][0], v1 = acc[ai][bj][m][1];
                    if (type == 1) { v0 = v0 * 0.125f; v1 = v1 * 0.125f; }
                    else if (type == 3) {
#pragma unroll
                        for (int j = 0; j < 4; ++j) { v0[j] = fast_sigmoid(v0[j]); v1[j] = fast_sigmoid(v1[j]); }
                    } else if (rot) {
                        f32x4 p0, p1;
#pragma unroll
                        for (int j = 0; j < 4; ++j) { p0[j] = __shfl_xor(v0[j], 16); p1[j] = __shfl_xor(v1[j], 16); }
                        if (fq == 0) { v0 = v0 * cs0 - p0 * sn0; v1 = v1 * cs1 - p1 * sn1; }
                        else if (fq == 1) { v0 = v0 * cs0 + p0 * sn0; v1 = v1 * cs1 + p1 * sn1; }
                    }
                    const int c512 = (pn & 1) * 256 + bj * HALF + wc * 32 + 8 * fq;
                    if (type >= 5 && valid) {
                        float* o = samp ? ((type == 5 ? oks : ovs) + (size_t)(row - E_MP) * 512 + c512) : ((type == 5 ? okp : ovp) + (size_t)row * 512 + c512);
                        *(f32x4*)o = v0; *(f32x4*)(o + 4) = v1;
                    }
                    if (type == 4) { v0 = v0 * (0.125f * 1.4426950408889634f); v1 = v1 * (0.125f * 1.4426950408889634f); }
                    u32x4 w; w.x = cvt_pk_bf16(v0[0], v0[1]); w.y = cvt_pk_bf16(v0[2], v0[3]); w.z = cvt_pk_bf16(v1[0], v1[1]); w.w = cvt_pk_bf16(v1[2], v1[3]);
                    *(u32x4*)(P + (size_t)row * 3072 + pn * BM + bj * HALF + wc * 32 + 8 * fq) = w;
                    if (type >= 5 && samp && valid) {
                        const int s = row - E_MP;
                        bf16_t* d = (type == 5 ? SK : SV) + ((size_t)((s >> 4) * 1088 + 1024 + (s & 15)) * 512 + c512);
                        *(u32x4*)d = w;
                    }
                }
            }
    }
};
template <class Epi, class Sched, bool ALIGN_EPI = false, bool SP2 = false, bool F8 = false  >
__device__ __forceinline__ void gemm_phase(PG8_LAS unsigned char* lds, const Gemm g, const Sched& S, const Epi& E) {
    int tid = threadIdx.x; asm volatile("" : "+v"(tid));
    const int wid = __builtin_amdgcn_readfirstlane(tid >> 6), lane = tid & 63, wr = wid >> 2, wc = wid & 3, fr = lane & 15, fq = lane >> 4;
    const int K = g.K, nt = K / BK;
    unsigned voffA[2], voffB[2];
    { int R, C; stage_rc(tid * 16, R, C); const int Rb = Epi::PERM ? ((R & ~31) + perm32(R & 31)) : R;
        voffA[0] = (unsigned)(R * K + C) * 2u; voffB[0] = (unsigned)(Rb * K + C) * 2u; voffA[1] = voffA[0] + (unsigned)(64 * K) * 2u; voffB[1] = voffB[0] + (unsigned)(64 * K) * 2u; }
    const size_t kstep = (size_t)(BK * 2);
    const size_t hstep = (size_t)HALF * K * 2;
    const size_t tstep = 2 * hstep;
    const unsigned ldsbase = (unsigned)(uintptr_t)lds; const size_t r64step = (size_t)(64 * K) * 2u;
    const unsigned ldsw = (unsigned)wid * 1024u;
    const int aoff = lds_byte(wr * 64 + fr, fq * 8), boff = lds_byte(wc * 32 + fr, fq * 8);
#define PG8_SA(b, h) (((b) * 2 + (h)) * HTB)
#define PG8_SB(b, h) ((4 + (b) * 2 + (h)) * HTB)
#define PG8_GLDS(vo, gp, ld) do { unsigned _keep; asm volatile("s_mov_b32 %0, m0\n\ts_mov_b32 m0, %3\n\ts_nop 0\n\tglobal_load_lds_dwordx4 %1, %2\n\ts_mov_b32 m0, %0" : "=&s"(_keep) : "v"(vo), "s"(gp), "s"(ld) : "memory"); } while (0)
#define PG8_STAGE(bufoff, gbase, voff) do { const char* _g = (const char*)(gbase); const unsigned _l = ldsbase + (unsigned)(bufoff) + ldsw; \
        PG8_GLDS((voff)[0], _g, _l); PG8_GLDS((voff)[0], _g + r64step, _l + 8192u); } while (0)
#define PG8_LDA(dst, b, h) do { _Pragma("unroll") for (int m = 0; m < 4; ++m) _Pragma("unroll") for (int k = 0; k < 2; ++k) dst[m][k] = *(const PG8_LAS v4i32*)(lds + PG8_SA(b, h) + aoff + m * 2048 + k * 1024); } while (0)
#define PG8_LDB(dst, b, h) do { _Pragma("unroll") for (int n = 0; n < 2; ++n) _Pragma("unroll") for (int k = 0; k < 2; ++k) dst[n][k] = *(const PG8_LAS v4i32*)(lds + PG8_SB(b, h) + boff + n * 2048 + k * 1024); } while (0)
#define PG8_CAT(x0, x1) __builtin_shufflevector(x0, x1, 0, 1, 2, 3, 4, 5, 6, 7)
#define PG8_MMA(ai, bj, At, Bt) do { __builtin_amdgcn_s_setprio(1); _Pragma("unroll") for (int m = 0; m < 4; ++m) _Pragma("unroll") for (int n = 0; n < 2; ++n) { \
        if constexpr (F8) { acc[ai][bj][m][n] = __builtin_amdgcn_mfma_scale_f32_16x16x128_f8f6f4(PG8_CAT(Bt[n][0], Bt[n][1]), PG8_CAT(At[m][0], At[m][1]), acc[ai][bj][m][n], 0, 0, 0, 0x7F7F7F7F, 0, 0x7F7F7F7F); } \
        else { _Pragma("unroll") for (int k = 0; k < 2; ++k) acc[ai][bj][m][n] = __builtin_amdgcn_mfma_f32_16x16x32_bf16(__builtin_bit_cast(bf16x8, Bt[n][k]), __builtin_bit_cast(bf16x8, At[m][k]), acc[ai][bj][m][n], 0, 0, 0); } } __builtin_amdgcn_s_setprio(0); } while (0)
#define PG8_WAIT_V(n) asm volatile("s_waitcnt vmcnt(" #n ")" ::: "memory")
#define PG8_WAIT_L(n) asm volatile("s_waitcnt lgkmcnt(" #n ")" ::: "memory")
#define PG8_BAR __builtin_amdgcn_s_barrier()
#define PG8_SCHED __builtin_amdgcn_sched_barrier(0)
    Unit cur, nxt; int ui = 0;
    if (!S.next(0, cur)) return;
    f32x4 acc[2][2][4][2];
#pragma unroll
    for (int a = 0; a < 2; ++a)
#pragma unroll
        for (int b = 0; b < 2; ++b)
#pragma unroll
            for (int m = 0; m < 4; ++m)
#pragma unroll
                for (int n = 0; n < 2; ++n) acc[a][b][m][n] = (f32x4){0.f, 0.f, 0.f, 0.f};
    v4i32 At[4][2], B0[2][2], B1[2][2];
    const char* cA = (const char*)g.A + (size_t)cur.pm * tstep; const char* cB = (const char*)g.Bt + (size_t)cur.pn * tstep;
    S.a_ready(cur);
    if constexpr (SP2) {
        PG8_STAGE(PG8_SB(0, 0), cB, voffB); PG8_STAGE(PG8_SB(0, 1), cB + hstep, voffB); PG8_STAGE(PG8_SA(0, 0), cA, voffA); PG8_STAGE(PG8_SA(0, 1), cA + hstep, voffA);
        if (wr == 1) PG8_BAR;
        PG8_WAIT_V(2); PG8_BAR;
        PG8_STAGE(PG8_SB(1, 0), cB + kstep, voffB); PG8_STAGE(PG8_SA(1, 0), cA + kstep, voffA); PG8_STAGE(PG8_SB(1, 1), cB + hstep + kstep, voffB);
        PG8_WAIT_V(6); PG8_BAR;
    } else {
        PG8_STAGE(PG8_SB(0, 0), cB, voffB); PG8_STAGE(PG8_SA(0, 0), cA, voffA); PG8_STAGE(PG8_SB(0, 1), cB + hstep, voffB); PG8_STAGE(PG8_SA(0, 1), cA + hstep, voffA);
        if (wr == 1) PG8_BAR;
        PG8_WAIT_V(4); PG8_BAR;
        PG8_STAGE(PG8_SB(1, 0), cB + kstep, voffB); PG8_STAGE(PG8_SA(1, 0), cA + kstep, voffA); PG8_STAGE(PG8_SB(1, 1), cB + hstep + kstep, voffB);
        PG8_WAIT_V(6); PG8_BAR;
    }
    for (;;) {
        const bool has_next = S.next(ui + 1, nxt);
        const char* nA = has_next ? (const char*)g.A + (size_t)nxt.pm * tstep : cA; const char* nB = has_next ? (const char*)g.Bt + (size_t)nxt.pn * tstep : cB;
#pragma unroll 1
        for (int t = 0; t < nt; t += 2) {
            const bool last = (t == nt - 2);
            const char* a1 = cA + (size_t)(t + 1) * kstep;
            const char* a2 = last ? nA : cA + (size_t)(t + 2) * kstep; const char* b2 = last ? nB : cB + (size_t)(t + 2) * kstep;
            const char* a3 = a2 + kstep; const char* b3 = b2 + kstep;
            if (last && has_next) S.a_ready(nxt);
            if constexpr (SP2) {
            PG8_LDB(B0, 0, 0); PG8_LDB(B1, 0, 1); PG8_SCHED; PG8_LDA(At, 0, 0); PG8_STAGE(PG8_SA(1, 1), a1 + hstep, voffA);
            PG8_WAIT_V(8); PG8_WAIT_L(0); PG8_BAR; PG8_MMA(0, 0, At, B0); PG8_MMA(0, 1, At, B1); PG8_BAR; PG8_SCHED;
            PG8_LDA(At, 0, 1); PG8_STAGE(PG8_SB(0, 0), b2, voffB); PG8_STAGE(PG8_SB(0, 1), b2 + hstep, voffB); PG8_STAGE(PG8_SA(0, 0), a2, voffA);
            PG8_WAIT_V(8); PG8_WAIT_L(0); PG8_BAR; PG8_MMA(1, 0, At, B0); PG8_MMA(1, 1, At, B1); PG8_BAR; PG8_SCHED;
            PG8_LDB(B0, 1, 0); PG8_LDB(B1, 1, 1); PG8_SCHED; PG8_LDA(At, 1, 0); PG8_STAGE(PG8_SA(0, 1), a2 + hstep, voffA);
            PG8_WAIT_V(8); PG8_WAIT_L(0); PG8_BAR; PG8_MMA(0, 0, At, B0); PG8_MMA(0, 1, At, B1); PG8_BAR; PG8_SCHED;
            PG8_LDA(At, 1, 1); PG8_STAGE(PG8_SB(1, 0), b3, voffB); PG8_STAGE(PG8_SB(1, 1), b3 + hstep, voffB); PG8_STAGE(PG8_SA(1, 0), a3, voffA);
            PG8_WAIT_V(8); PG8_WAIT_L(0); PG8_BAR; PG8_MMA(1, 0, At, B0); PG8_MMA(1, 1, At, B1); PG8_BAR; PG8_SCHED;
            } else {
            PG8_LDB(B0, 0, 0); PG8_SCHED; PG8_LDA(At, 0, 0); PG8_STAGE(PG8_SA(1, 1), a1 + hstep, voffA);
            PG8_WAIT_L(8); PG8_BAR; PG8_WAIT_L(0); PG8_MMA(0, 0, At, B0); PG8_BAR; PG8_SCHED;
            PG8_LDB(B1, 0, 1); PG8_STAGE(PG8_SB(0, 0), b2, voffB);
            PG8_BAR; PG8_WAIT_L(0); PG8_MMA(0, 1, At, B1); PG8_BAR;
            PG8_LDA(At, 0, 1); PG8_STAGE(PG8_SA(0, 0), a2, voffA);
            PG8_BAR; PG8_WAIT_L(0); PG8_MMA(1, 0, At, B0); PG8_BAR; PG8_SCHED;
            PG8_STAGE(PG8_SB(0, 1), b2 + hstep, voffB);
            PG8_WAIT_V(6); PG8_BAR; PG8_MMA(1, 1, At, B1); PG8_BAR;
            PG8_LDB(B0, 1, 0); PG8_SCHED; PG8_LDA(At, 1, 0); PG8_STAGE(PG8_SA(0, 1), a2 + hstep, voffA);
            PG8_WAIT_L(8); PG8_BAR; PG8_WAIT_L(0); PG8_MMA(0, 0, At, B0); PG8_BAR; PG8_SCHED;
            PG8_LDB(B1, 1, 1); PG8_STAGE(PG8_SB(1, 0), b3, voffB);
            PG8_BAR; PG8_WAIT_L(0); PG8_MMA(0, 1, At, B1); PG8_BAR;
            PG8_LDA(At, 1, 1); PG8_STAGE(PG8_SA(1, 0), a3, voffA);
            PG8_BAR; PG8_WAIT_L(0); PG8_MMA(1, 0, At, B0); PG8_BAR; PG8_SCHED;
            PG8_STAGE(PG8_SB(1, 1), b3 + hstep, voffB);
            PG8_WAIT_V(6); PG8_BAR; PG8_MMA(1, 1, At, B1); PG8_BAR;
            }
        }
        if constexpr (ALIGN_EPI) { if (wr == 0) PG8_BAR; }
        if constexpr (!Epi::AFTER_DRAIN) { E(acc, cur, wr, wc, fr, fq); S.done(cur); }
        if (!has_next) break;
#pragma unroll
        for (int a = 0; a < 2; ++a)
#pragma unroll
            for (int b = 0; b < 2; ++b)
#pragma unroll
                for (int m = 0; m < 4; ++m)
#pragma unroll
                    for (int n = 0; n < 2; ++n) acc[a][b][m][n] = (f32x4){0.f, 0.f, 0.f, 0.f};
        cur = nxt; cA = nA; cB = nB; ++ui;
        if constexpr (ALIGN_EPI) { if (wr == 1) PG8_BAR; }
    }
    PG8_WAIT_V(0);
    if constexpr (!ALIGN_EPI) { if (wr == 0) PG8_BAR; }
    PG8_BAR;
    if constexpr (Epi::AFTER_DRAIN) { E.fused(acc, cur, wr, wc, fr, fq, lds, wid, lane); S.done(cur); }
#undef PG8_SA
#undef PG8_SB
#undef PG8_STAGE
#undef PG8_GLDS
#undef PG8_LDA
#undef PG8_LDB
#undef PG8_MMA
#undef PG8_CAT
#undef PG8_WAIT_V
#undef PG8_WAIT_L
#undef PG8_BAR
#undef PG8_SCHED
}
}
namespace cg = cooperative_groups;
#define LAS __attribute__((address_space(3)))
typedef unsigned short bf16_t;
typedef short bf16x8 __attribute__((ext_vector_type(8)));
typedef short s16x4 __attribute__((ext_vector_type(4)));
typedef short v4i16_t __attribute__((ext_vector_type(4)));
typedef float f32x4 __attribute__((ext_vector_type(4)));
typedef float f32x16 __attribute__((ext_vector_type(16)));
typedef unsigned u32x4 __attribute__((ext_vector_type(4)));
typedef unsigned u32x2 __attribute__((ext_vector_type(2)));

constexpr int NWAVES = 8, NTHR = 512;
constexpr int D = 1024, SEQ = 2048, NBATCH = 32, FF = 2816, NPROJ = 3072;
constexpr int MP = 65536, MS = 128, MV = MP + MS, MPAD = 65792;
constexpr float EPS = 1e-6f;
constexpr int LDS_BYTES = 147456;
constexpr size_t O_Y = 0, O_KP = 67239936, O_VP = O_KP + 33554432, O_CP = O_VP + 33554432, O_NP = O_CP + 1048576, O_MPR = O_NP + 8192,
                 O_KS = O_MPR + 128, O_VS = O_KS + 65536, O_CS = O_VS + 65536, O_NS = O_CS + 262144, O_MS = O_NS + 2048, O_END = O_MS + 32;
constexpr size_t MiB = 1u << 20;
constexpr size_t WS_CTL = 0, WS_MOD = 1 * MiB, WS_ROPE = 3 * MiB, WS_GATES = 4 * MiB, WS_W1I = 8 * MiB, WS_W1O = 20 * MiB, WS_WIN = 26 * MiB, WS_WO = 32 * MiB,
                 WS_W2I = 34 * MiB, WS_W2O = 46 * MiB, WS_SK = 52 * MiB, WS_SV = 61 * MiB, WS_H = 72 * MiB, WS_F = 202 * MiB, WS_P = 332 * MiB, WS_W1I8 = 720 * MiB, WS_W2I8 = 726 * MiB, WS_W2O8 = 732 * MiB, WS_X16 = 736 * MiB, WS_END = 866 * MiB;
constexpr float H8_SCALE = 8.0f, W8_SCALE = 256.0f, A8_SCALE = 4.0f;

typedef float f32x2c __attribute__((ext_vector_type(2))); typedef __bf16 bf16x2c __attribute__((ext_vector_type(2)));
__device__ __forceinline__ unsigned pk2(float lo, float hi) { const f32x2c v = {lo, hi}; return __builtin_bit_cast(unsigned, __builtin_convertvector(v, bf16x2c)); }
__device__ __forceinline__ unsigned f2bf(float f) { return pk2(f, f) & 0xffffu; }
__device__ __forceinline__ float bflo(unsigned u) { return __uint_as_float(u << 16); }
__device__ __forceinline__ float bfhi(unsigned u) { return __uint_as_float(u & 0xffff0000u); }
template <int CTRL> __device__ __forceinline__ float dpp_mov(float v) { return __int_as_float(__builtin_amdgcn_update_dpp(0, __float_as_int(v), CTRL, 0xf, 0xf, false)); }
__device__ __forceinline__ float wave_sum(float v) {
    v += dpp_mov<0xB1>(v); v += dpp_mov<0x4E>(v); v += dpp_mov<0x141>(v); v += dpp_mov<0x140>(v);
    const int iv = __float_as_int(v);
    const float r0 = __int_as_float(__builtin_amdgcn_readlane(iv, 0)), r1 = __int_as_float(__builtin_amdgcn_readlane(iv, 16)), r2 = __int_as_float(__builtin_amdgcn_readlane(iv, 32)), r3 = __int_as_float(__builtin_amdgcn_readlane(iv, 48));
    return (r0 + r1) + (r2 + r3);
}
__device__ __forceinline__ int crow(int r, int hi) { return (r & 3) + 8 * (r >> 2) + 4 * hi; }

struct Args { const float* in[23]; float* out; unsigned char* ws; int ph_lo, ph_hi; };

__device__ __forceinline__ unsigned pk4_fp8(float a, float b, float c, float d) { unsigned p = 0u; p = __builtin_amdgcn_cvt_pk_fp8_f32(a, b, p, false); p = __builtin_amdgcn_cvt_pk_fp8_f32(c, d, p, true); return p; }
__device__ __forceinline__ void p0_transpose_item(const float* W, int K, int N, bf16_t* WT, int k0, int sc0, int dr0, LAS float* scr, int lane, unsigned char* WT8 = nullptr) {
    float wv[32];
#pragma unroll
    for (int i = 0; i < 32; ++i) wv[i] = W[(size_t)(k0 + 2 * i + (lane >> 5)) * N + sc0 + (lane & 31)];
#pragma unroll
    for (int i = 0; i < 32; ++i) scr[(2 * i + (lane >> 5)) * 33 + (lane & 31)] = wv[i];
    asm volatile("s_waitcnt lgkmcnt(0)" ::: "memory");
    const int c = lane & 7;
#pragma unroll
    for (int j = 0; j < 4; ++j) { const int n = (lane >> 3) + 8 * j; const LAS float* s = scr + (8 * c) * 33 + n;
        u32x4 o; o.x = pk2(s[0 * 33], s[1 * 33]); o.y = pk2(s[2 * 33], s[3 * 33]); o.z = pk2(s[4 * 33], s[5 * 33]); o.w = pk2(s[6 * 33], s[7 * 33]);
        *(u32x4*)(WT + (size_t)(dr0 + n) * K + k0 + 8 * c) = o; }
    if (WT8) {
        const int c4 = lane & 3;
#pragma unroll
        for (int j = 0; j < 2; ++j) { const int n = (lane >> 2) + 16 * j; const LAS float* s = scr + (16 * c4) * 33 + n;
            u32x4 o; o.x = pk4_fp8(s[0] * W8_SCALE, s[33] * W8_SCALE, s[66] * W8_SCALE, s[99] * W8_SCALE); o.y = pk4_fp8(s[132] * W8_SCALE, s[165] * W8_SCALE, s[198] * W8_SCALE, s[231] * W8_SCALE);
            o.z = pk4_fp8(s[264] * W8_SCALE, s[297] * W8_SCALE, s[330] * W8_SCALE, s[363] * W8_SCALE); o.w = pk4_fp8(s[396] * W8_SCALE, s[429] * W8_SCALE, s[462] * W8_SCALE, s[495] * W8_SCALE);
            *(u32x4*)(WT8 + (size_t)(dr0 + n) * K + k0 + 16 * c4) = o; }
    }
    asm volatile("s_waitcnt lgkmcnt(0)" ::: "memory");
}
__device__ __forceinline__ int ffn_in_src(int dr0) { const int tile = dr0 >> 8, w0 = dr0 & 255; return (w0 < 128) ? (128 * tile + w0) : (FF + 128 * tile + w0 - 128); }

__device__ __forceinline__ void p0_prologue(const Args& a, LAS unsigned char* lds) {
    int tid = threadIdx.x; asm volatile("" : "+v"(tid));
    const int lane = tid & 63, wave = __builtin_amdgcn_readfirstlane(tid >> 6);
    const int G = gridDim.x;
    unsigned char* ws = a.ws;
    if (blockIdx.x == 0 && wave == 0) {
        const float* lq = a.in[19];
        float a0 = lq[lane] * lq[64 + lane], a1 = lq[128 + lane] * lq[192 + lane];
        a0 = wave_sum(a0); a1 = wave_sum(a1);
        if (lane == 0) { ((float*)(ws + WS_CTL))[64] = __expf(a0) - __expf(a1) + 0.2f; }
    }
    {
        const float* cp = a.in[7]; const float* csm = a.in[8]; const float* wada = a.in[9]; const float* bada = a.in[10];
        float* mod = (float*)(ws + WS_MOD);
        LAS float* sct = (LAS float*)lds;
        LAS float* red = (LAS float*)(lds + 81920);
        for (int it = blockIdx.x; it < 576; it += G) {
            const int cgp = it >> 1, rh = it & 1;
            for (int i = tid; i < 20480; i += NTHR) { const int rr = i >> 10, k = i & 1023, grow = 20 * rh + rr;
                const float c = grow < 32 ? cp[grow * 1024 + k] : csm[(grow - 32) * 1024 + k];
                sct[k * 20 + rr] = c * __builtin_amdgcn_rcpf(1.0f + __expf(-c)); }
            __syncthreads();
            const int col = tid & 31, ks = tid >> 5;
            float acc[20];
#pragma unroll
            for (int r = 0; r < 20; ++r) acc[r] = 0.f;
            const float* wp = wada + (size_t)(64 * ks) * 9216 + 32 * cgp + col;
            float wv[64];
#pragma unroll
            for (int kk = 0; kk < 64; ++kk) wv[kk] = wp[(size_t)kk * 9216];
#pragma unroll
            for (int kk = 0; kk < 64; ++kk) {
                const float w = wv[kk];
                const LAS f32x4* s4 = (const LAS f32x4*)(sct + (64 * ks + kk) * 20);
#pragma unroll
                for (int q = 0; q < 5; ++q) { const f32x4 s = s4[q]; acc[4 * q] += s[0] * w; acc[4 * q + 1] += s[1] * w; acc[4 * q + 2] += s[2] * w; acc[4 * q + 3] += s[3] * w; }
            }
#pragma unroll
            for (int r = 0; r < 20; ++r) red[(ks * 20 + r) * 32 + col] = acc[r];
            __syncthreads();
            for (int i = tid; i < 640; i += NTHR) { const int r = i >> 5, c2 = i & 31; float s = bada[32 * cgp + c2];
#pragma unroll
                for (int k2 = 0; k2 < 16; ++k2) s += red[(k2 * 20 + r) * 32 + c2];
                mod[(size_t)(20 * rh + r) * 9216 + 32 * cgp + c2] = s; }
            __syncthreads();
        }
    }
    {
        LAS float* scr = (LAS float*)(lds + wave * 16384);
        const int gw = blockIdx.x * NWAVES + wave, NGW = G * NWAVES;
        constexpr int I_1I = 16 * 176, I_1O = 44 * 32, I_IN = 16 * 96, I_O = 16 * 32;
        constexpr int NITEMS = 2 * I_1I + 2 * I_1O + I_IN + I_O;
        for (int it = gw; it < NITEMS; it += NGW) {
            int r = it;
            if (r < I_1I) { const int kb = r / 176, nb = r % 176; p0_transpose_item(a.in[12], D, 2 * FF, (bf16_t*)(ws + WS_W1I), 64 * kb, ffn_in_src(32 * nb), 32 * nb, scr, lane); continue; } r -= I_1I;
            if (r < I_1I) { const int kb = r / 176, nb = r % 176; p0_transpose_item(a.in[21], D, 2 * FF, (bf16_t*)(ws + WS_W2I), 64 * kb, ffn_in_src(32 * nb), 32 * nb, scr, lane, ws + WS_W2I8); continue; } r -= I_1I;
            if (r < I_1O) { const int kb = r / 32, nb = r % 32; p0_transpose_item(a.in[13], FF, D, (bf16_t*)(ws + WS_W1O), 64 * kb, 32 * nb, 32 * nb, scr, lane); continue; } r -= I_1O;
            if (r < I_1O) { const int kb = r / 32, nb = r % 32; p0_transpose_item(a.in[22], FF, D, (bf16_t*)(ws + WS_W2O), 64 * kb, 32 * nb, 32 * nb, scr, lane, ws + WS_W2O8); continue; } r -= I_1O;
            if (r < I_IN) { const int kb = r / 96, nb = r % 96; p0_transpose_item(a.in[14], D, 3080, (bf16_t*)(ws + WS_WIN), 64 * kb, 32 * nb + (nb >= 48 ? 8 : 0), 32 * nb, scr, lane); continue; } r -= I_IN;
            { const int kb = r / 32, nb = r % 32; p0_transpose_item(a.in[20], D, D, (bf16_t*)(ws + WS_WO), 64 * kb, 32 * nb, 32 * nb, scr, lane); }
        }
    }
    {
        const int gt = blockIdx.x * NTHR + tid, NGT = G * NTHR;
        for (int i = gt; i < 2 * 524288; i += NGT) {
            const int ten = i >> 19, j = i & 524287, b = j >> 16, rem = j & 65535, pos = rem >> 6, ch = rem & 63;
            const float* src = a.in[2 + ten] + ((size_t)(b * 1024 + pos) * 512 + ch * 8);
            const f32x4 x0 = *(const f32x4*)src, x1 = *(const f32x4*)(src + 4);
            u32x4 o; o.x = pk2(x0[0], x0[1]); o.y = pk2(x0[2], x0[3]); o.z = pk2(x1[0], x1[1]); o.w = pk2(x1[2], x1[3]);
            *(u32x4*)((bf16_t*)(ws + (ten ? WS_SV : WS_SK)) + ((size_t)(b * 1088 + pos) * 512 + ch * 8)) = o;
        }
        float* rope = (float*)(ws + WS_ROPE);
        for (int i = gt; i < 2048 * 8; i += NGT) {
            const int pos = i >> 3, fi = i & 7;
            const double invf = fi == 0 ? 1.0 : fi == 1 ? 0.19392274474868576 : fi == 2 ? 0.03760603093086393 : fi == 3 ? 0.007292664737217109 : fi == 4 ? 0.001414213562373095
                              : fi == 5 ? 0.0002742481756762073 : fi == 6 ? 5.318295896944988e-05 : 1.031338537721246e-05;
            const double ang = (double)pos * invf;
            const double n = __builtin_rint(ang * 0.15915494309189535);
            const double rr = __builtin_fma(-n, 6.283185307179586, ang);
            const double kq = __builtin_rint(rr * 0.6366197723675814);
            const double y = __builtin_fma(-kq, 1.5707963267948966, rr), y2 = y * y;
            const double sn = y * (1.0 - y2 / 6.0 * (1.0 - y2 / 20.0 * (1.0 - y2 / 42.0 * (1.0 - y2 / 72.0 * (1.0 - y2 / 110.0 * (1.0 - y2 / 156.0))))));
            const double cs = 1.0 - y2 / 2.0 * (1.0 - y2 / 12.0 * (1.0 - y2 / 30.0 * (1.0 - y2 / 56.0 * (1.0 - y2 / 90.0 * (1.0 - y2 / 132.0)))));
            const int q = ((int)kq) & 3;
            const double c = q == 0 ? cs : q == 1 ? -sn : q == 2 ? -cs : sn;
            const double s = q == 0 ? sn : q == 1 ? cs : q == 2 ? -sn : -cs;
            rope[pos * 16 + fi] = (float)c; rope[pos * 16 + 8 + fi] = (float)s;
        }
    }
}

template <bool HAS_F, bool HAS_H, bool GATES, bool H8 = false  , bool XIN16 = false, bool XOUT16 = false  >
__device__ __forceinline__ void row_phase(const Args& a, LAS unsigned char* lds, const float* xin_p, const float* xin_s, float* xout, int kg, float rw, int gpost, int gpre, int ksh, int ksc) {
    int tid = threadIdx.x; asm volatile("" : "+v"(tid));
    const int lane = tid & 63, wave = __builtin_amdgcn_readfirstlane(tid >> 6);
    const int gw = blockIdx.x * NWAVES + wave, NGW = gridDim.x * NWAVES;
    unsigned char* ws = a.ws;
    const float* mod = (const float*)(ws + WS_MOD);
    const float* gn = a.in[11];
    const bf16_t* F = (const bf16_t*)(ws + WS_F);
    bf16_t* H = (bf16_t*)(ws + WS_H); bf16_t* X16 = (bf16_t*)(ws + WS_X16);
    float* gates = (float*)(ws + WS_GATES);
    LAS float* wg = (LAS float*)lds;
    if (GATES) {
        const float* win = a.in[14];
        for (int i = tid; i < 8192; i += NTHR) wg[i] = win[(size_t)(i >> 3) * 3080 + 1536 + (i & 7)];
        __syncthreads();
    }
    if (HAS_H && !HAS_F) {
        for (int i = blockIdx.x * NTHR + tid; i < (MPAD - MV) * D / 8; i += gridDim.x * NTHR) *(u32x4*)(H + (size_t)MV * D + (size_t)i * 8) = (u32x4){0u, 0u, 0u, 0u};
    }
    for (int ch = gw; ch < 2048 + MS; ch += NGW) {
        const bool samp = ch >= 2048;
        const int row0 = samp ? MP + (ch - 2048) : ch * 32, nrows = samp ? 1 : 32;
        const int mb = samp ? 32 + ((ch - 2048) >> 4) : (ch >> 6);
        const float* mrow = mod + (size_t)mb * 9216;
        f32x4 A1[4], A2[4], A3[4];
#pragma unroll
        for (int j = 0; j < 4; ++j) {
            const int e = 4 * lane + 256 * j;
            if (HAS_F && !GATES) { const f32x4 mg = *(const f32x4*)(mrow + kg * 1024 + e), gp = *(const f32x4*)(gn + gpost * 1024 + e); A1[j] = mg * gp * rw; }
            if (HAS_H) { const f32x4 gp = *(const f32x4*)(gn + gpre * 1024 + e), sc = *(const f32x4*)(mrow + ksc * 1024 + e); A2[j] = gp * (sc + 1.0f); if (!GATES) A3[j] = *(const f32x4*)(mrow + ksh * 1024 + e); }
        }
        for (int rr = 0; rr < nrows; ++rr) {
            const int row = row0 + rr;
            const float* xr = samp ? xin_s + (size_t)(row - MP) * D : xin_p + (size_t)row * D;
            f32x4 x[4];
#pragma unroll
            for (int j = 0; j < 4; ++j) {
                if (XIN16) { const u32x2 u = *(const u32x2*)(X16 + (size_t)row * D + 4 * lane + 256 * j); x[j] = (f32x4){bflo(u.x), bfhi(u.x), bflo(u.y), bfhi(u.y)}; }
                else x[j] = *(const f32x4*)(xr + 4 * lane + 256 * j);
            }
            if (HAS_F) {
                f32x4 f[4]; float ss = 0.f;
#pragma unroll
                for (int j = 0; j < 4; ++j) { const u32x2 u = *(const u32x2*)(F + (size_t)row * D + 4 * lane + 256 * j);
                    f[j] = (f32x4){bflo(u.x), bfhi(u.x), bflo(u.y), bfhi(u.y)}; ss += (f[j][0] * f[j][0] + f[j][1] * f[j][1]) + (f[j][2] * f[j][2] + f[j][3] * f[j][3]); }
                const float rstd = __builtin_amdgcn_rsqf(wave_sum(ss) * (1.0f / D) + EPS);
#pragma unroll
                for (int j = 0; j < 4; ++j) { f32x4 a1; if (GATES) { const int e = 4 * lane + 256 * j; a1 = *(const f32x4*)(mrow + kg * 1024 + e) * *(const f32x4*)(gn + gpost * 1024 + e) * rw; } else a1 = A1[j];
                    x[j] = x[j] + a1 * f[j] * rstd;
                    if (XOUT16) { u32x2 o; o.x = pk2(x[j][0], x[j][1]); o.y = pk2(x[j][2], x[j][3]); *(u32x2*)(X16 + (size_t)row * D + 4 * lane + 256 * j) = o; }
                    else *(f32x4*)(xout + (size_t)row * D + 4 * lane + 256 * j) = x[j]; }
            }
            if (HAS_H) {
                float ss = 0.f;
#pragma unroll
                for (int j = 0; j < 4; ++j) ss += (x[j][0] * x[j][0] + x[j][1] * x[j][1]) + (x[j][2] * x[j][2] + x[j][3] * x[j][3]);
                const float rstd = __builtin_amdgcn_rsqf(wave_sum(ss) * (1.0f / D) + EPS);
                f32x4 h[4];
#pragma unroll
                for (int j = 0; j < 4; ++j) { const f32x4 sh = GATES ? *(const f32x4*)(mrow + ksh * 1024 + 4 * lane + 256 * j) : A3[j]; h[j] = x[j] * rstd * A2[j] + sh;
                    if (H8 && !samp) { *(unsigned*)((unsigned char*)H + (size_t)row * D + 4 * lane + 256 * j) = pk4_fp8(h[j][0] * H8_SCALE, h[j][1] * H8_SCALE, h[j][2] * H8_SCALE, h[j][3] * H8_SCALE); }
                    else { u32x2 o; o.x = pk2(h[j][0], h[j][1]); o.y = pk2(h[j][2], h[j][3]); *(u32x2*)(H + (size_t)row * D + 4 * lane + 256 * j) = o; } }
                if (GATES) {
                    float g[8];
#pragma unroll
                    for (int q = 0; q < 8; ++q) g[q] = 0.f;
#pragma unroll
                    for (int j = 0; j < 4; ++j)
#pragma unroll
                        for (int e = 0; e < 4; ++e) { const LAS f32x4* wp = (const LAS f32x4*)(wg + (4 * lane + 256 * j + e) * 8); const f32x4 w0 = wp[0], w1 = wp[1]; const float hv = h[j][e];
                            g[0] += hv * w0[0]; g[1] += hv * w0[1]; g[2] += hv * w0[2]; g[3] += hv * w0[3]; g[4] += hv * w1[0]; g[5] += hv * w1[1]; g[6] += hv * w1[2]; g[7] += hv * w1[3]; }
#pragma unroll
                    for (int q = 0; q < 8; ++q) g[q] = wave_sum(g[q]);
                    const float gsel = lane == 0 ? g[0] : lane == 1 ? g[1] : lane == 2 ? g[2] : lane == 3 ? g[3] : lane == 4 ? g[4] : lane == 5 ? g[5] : lane == 6 ? g[6] : g[7];
                    if (lane < 8) {
                        float v;
                        if (lane < 4) v = gsel + a.in[15][lane];
                        else { const float z = gsel + a.in[16][lane - 4]; v = fminf(z, 0.f) - log1pf(__expf(-fabsf(z))); }
                        gates[(size_t)row * 8 + lane] = v;
                    }
                }
            }
        }
    }
}
typedef LAS unsigned char* ldsp;
__device__ __forceinline__ bf16x8 lds_frag(ldsp p) { return *(const LAS bf16x8*)p; }
__device__ __forceinline__ s16x4 vtr(ldsp p) { return __builtin_bit_cast(s16x4, __builtin_amdgcn_ds_read_tr16_b64_v4i16((LAS v4i16_t*)p)); }
__device__ __forceinline__ bf16x8 vtr2(ldsp p) { const s16x4 lo = vtr(p), hi = vtr(p + 512); return (bf16x8){lo[0], lo[1], lo[2], lo[3], hi[0], hi[1], hi[2], hi[3]}; }
__device__ __forceinline__ bf16x8 pack8(const f32x16& p, int s) {
    u32x4 w; w.x = pg8::cvt_pk_bf16(p[8 * s + 0], p[8 * s + 1]); w.y = pg8::cvt_pk_bf16(p[8 * s + 2], p[8 * s + 3]); w.z = pg8::cvt_pk_bf16(p[8 * s + 4], p[8 * s + 5]); w.w = pg8::cvt_pk_bf16(p[8 * s + 6], p[8 * s + 7]);
    return __builtin_bit_cast(bf16x8, w);
}
__device__ __forceinline__ int rimg(int row, int c, int nrows) { return c * nrows * 16 + ((row ^ (c & 7)) * 16); }
__device__ __forceinline__ int timg(int s, int c16) { return (c16 >> 2) * 4096 + (s >> 3) * 512 + (s & 7) * 64 + (c16 & 3) * 16; }

constexpr float LOG2E = 1.4426950408889634f;
__device__ __forceinline__ float max3f(float a, float b, float c) { float r; asm("v_max3_f32 %0, %1, %2, %3" : "=v"(r) : "v"(a), "v"(b), "v"(c)); return r; }
constexpr float AT_THR = 8.0f;
constexpr int AT_Q = 0, AT_KV = 32768, AT_KVB = 32768, AT_V = 16384, AT_X = 0;

__device__ __forceinline__ void attn_unit(ldsp lds, const bf16_t* Qg, int qstride, int nq_valid, const bf16_t* Kg, const bf16_t* Vg, int kvstride, int NT, int lim, int nvalid_last,
                                          bf16_t* Og, const float* gd, float lam) {
    int tid = threadIdx.x; asm volatile("" : "+v"(tid));
    const int lane = tid & 63, w = __builtin_amdgcn_readfirstlane(tid >> 6), r32 = lane & 31, hi = lane >> 5;
    const int rg = w >> 1, c = w & 1;
#pragma unroll
    for (int i = 0; i < 4; ++i) { const int id = tid + NTHR * i, row = id >> 4, c16 = id & 15, srow = row < nq_valid ? row : 0;
        const u32x4 v = *(const u32x4*)(Qg + (size_t)srow * qstride + c16 * 8);
        *(LAS u32x4*)(lds + AT_Q + rimg(row, c16, 128)) = v; }
    const int key0 = tid >> 4, cc = tid & 15;
    const bf16_t* kp = Kg + (size_t)key0 * kvstride + cc * 8; const bf16_t* vp = Vg + (size_t)key0 * kvstride + cc * 8;
    u32x4 kr0, kr1, vr0, vr1;
    kr0 = *(const u32x4*)kp; kr1 = *(const u32x4*)(kp + (size_t)32 * kvstride); vr0 = *(const u32x4*)vp; vr1 = *(const u32x4*)(vp + (size_t)32 * kvstride);
    f32x16 O[4];
#pragma unroll
    for (int d = 0; d < 4; ++d)
#pragma unroll
        for (int r = 0; r < 16; ++r) O[d][r] = 0.f;
    float lrun = 0.f;
    f32x16 negm;
#pragma unroll
    for (int r = 0; r < 16; ++r) negm[r] = 0.f;
    const int vlane = ((lane >> 4) & 1) * 32 + (lane & 3) * 8 + (4 * hi + ((lane & 15) >> 2)) * 64;
    for (int j = 0; j < NT; ++j) {
        const ldsp kb = lds + AT_KV + (j & 1) * AT_KVB; const ldsp vb = kb + AT_V;
        *(LAS u32x4*)(kb + rimg(key0, cc, 64)) = kr0; *(LAS u32x4*)(kb + rimg(key0 + 32, cc, 64)) = kr1;
        *(LAS u32x4*)(vb + timg(key0, cc)) = vr0; *(LAS u32x4*)(vb + timg(key0 + 32, cc)) = vr1;
        __syncthreads();
        if (j + 1 < NT) { const size_t o = (size_t)(64 * (j + 1)) * kvstride;
            kr0 = *(const u32x4*)(kp + o); kr1 = *(const u32x4*)(kp + o + (size_t)32 * kvstride); vr0 = *(const u32x4*)(vp + o); vr1 = *(const u32x4*)(vp + o + (size_t)32 * kvstride); }
        if (j <= lim) {
            const bool maskt = (j == NT - 1) && (nvalid_last < 64);
            f32x16 s0 = negm, s1 = negm;
#pragma unroll
            for (int st = 0; st < 4; ++st) {
                const int c16 = 8 * c + 2 * st + hi;
                const bf16x8 qf = lds_frag(lds + AT_Q + rimg(32 * rg + r32, c16, 128));
                const bf16x8 k0 = lds_frag(kb + rimg(r32, c16, 64)), k1 = lds_frag(kb + rimg(32 + r32, c16, 64));
                s0 = __builtin_amdgcn_mfma_f32_32x32x16_bf16(k0, qf, s0, 0, 0, 0);
                s1 = __builtin_amdgcn_mfma_f32_32x32x16_bf16(k1, qf, s1, 0, 0, 0);
            }
            if (maskt) {
#pragma unroll
                for (int r = 0; r < 16; ++r) { const int key = crow(r, hi); if (key >= nvalid_last) s0[r] = -INFINITY; if (key + 32 >= nvalid_last) s1[r] = -INFINITY; }
            }
            float mx = -INFINITY;
#pragma unroll
            for (int r = 0; r < 16; ++r) mx = max3f(mx, s0[r], s1[r]);
            mx = fmaxf(mx, __shfl_xor(mx, 32));
            if (j == 0 || __builtin_amdgcn_ballot_w64(mx > AT_THR) != 0ull) {
                const float delta = (j == 0) ? mx : fmaxf(mx, 0.f);
                const float alpha = (j == 0) ? 1.0f : __builtin_amdgcn_exp2f(-delta);
                lrun *= alpha;
#pragma unroll
                for (int r = 0; r < 16; ++r) { negm[r] -= delta; s0[r] -= delta; s1[r] -= delta; }
#pragma unroll
                for (int d = 0; d < 4; ++d)
#pragma unroll
                    for (int r = 0; r < 16; ++r) O[d][r] *= alpha;
            }
            float rs = 0.f;
#pragma unroll
            for (int r = 0; r < 16; ++r) { s0[r] = __builtin_amdgcn_exp2f(s0[r]); s1[r] = __builtin_amdgcn_exp2f(s1[r]); rs += s0[r] + s1[r]; }
            rs += __shfl_xor(rs, 32);
            lrun += rs;
            const bf16x8 pf0 = pack8(s0, 0), pf1 = pack8(s0, 1), pf2 = pack8(s1, 0), pf3 = pack8(s1, 1);
#pragma unroll
            for (int d = 0; d < 4; ++d) {
                const ldsp vq = vb + vlane + d * 4096;
                O[d] = __builtin_amdgcn_mfma_f32_32x32x16_bf16(vtr2(vq), pf0, O[d], 0, 0, 0);
                O[d] = __builtin_amdgcn_mfma_f32_32x32x16_bf16(vtr2(vq + 1024), pf1, O[d], 0, 0, 0);
                O[d] = __builtin_amdgcn_mfma_f32_32x32x16_bf16(vtr2(vq + 2048), pf2, O[d], 0, 0, 0);
                O[d] = __builtin_amdgcn_mfma_f32_32x32x16_bf16(vtr2(vq + 3072), pf3, O[d], 0, 0, 0);
            }
        }
    }
    __syncthreads();
    LAS float* xch = (LAS float*)(lds + AT_X) + rg * 4096 + lane;
    if (lim >= 0 && c == 1) {
        const float i1 = lam / lrun;
#pragma unroll
        for (int d = 0; d < 4; ++d)
#pragma unroll
            for (int r = 0; r < 16; ++r) xch[(d * 16 + r) * 64] = O[d][r] * i1;
    }
    __syncthreads();
    if (lim >= 0 && c == 0) {
        const float i0 = 1.0f / lrun;
        float ss = 0.f;
#pragma unroll
        for (int d = 0; d < 4; ++d)
#pragma unroll
            for (int r = 0; r < 16; ++r) { const float o = O[d][r] * i0 - xch[(d * 16 + r) * 64]; O[d][r] = o; ss += o * o; }
        ss += __shfl_xor(ss, 32);
        const float rstd = __builtin_amdgcn_rsqf(ss * (1.0f / 128.0f) + EPS) * 0.8f;
        const int q = 32 * rg + r32;
        if (q < nq_valid) {
            bf16_t* orow = Og + (size_t)q * D;
#pragma unroll
            for (int d = 0; d < 4; ++d)
#pragma unroll
                for (int g4 = 0; g4 < 4; ++g4) { const int dd = 32 * d + 8 * g4 + 4 * hi; const f32x4 gv = *(const f32x4*)(gd + dd);
                    u32x2 o; o.x = pk2(O[d][4 * g4] * rstd * gv[0], O[d][4 * g4 + 1] * rstd * gv[1]); o.y = pk2(O[d][4 * g4 + 2] * rstd * gv[2], O[d][4 * g4 + 3] * rstd * gv[3]);
                    *(u32x2*)(orow + dd) = o; }
        }
    }
}

constexpr int ML_BUFB = 40960, ML_Q = 0, ML_K = 8192, ML_KT = 16384, ML_V = 24576;
constexpr int ML_C = 81920, ML_A = 98304, ML_G = 106496, ML_B = 114688, ML_MP = 122880, ML_N = 123136, ML_SS = 123392;
__device__ __forceinline__ void mlstm_unit(ldsp lds, const bf16_t* Pb  , const float* gates  , int h, int nch, int ntok,
                                           const float* C0, const float* n0, const float* m0, bf16_t* Hb  , const float* gm  ,
                                           float* Cout, float* nout, float* mout) {
    int tid = threadIdx.x; asm volatile("" : "+v"(tid));
    const int lane = tid & 63, w = __builtin_amdgcn_readfirstlane(tid >> 6), r32 = lane & 31, hi = lane >> 5;
    const int T = nch * 64;
    LAS float* la = (LAS float*)(lds + ML_A); LAS float* lg = (LAS float*)(lds + ML_G); LAS float* lb = (LAS float*)(lds + ML_B);
    LAS float* lmp = (LAS float*)(lds + ML_MP); LAS float* ln = (LAS float*)(lds + ML_N); LAS float* lss = (LAS float*)(lds + ML_SS);
    for (int t = tid; t < T; t += NTHR) { const bool ok = (t & 63) < ntok; const int rowt = (t >> 6) * 64 + (t & 63);
        la[t] = ok ? gates[(size_t)rowt * 8 + h] : -1e30f; lb[t] = ok ? gates[(size_t)rowt * 8 + 4 + h] : 0.f; }
    if (tid < 64) *(LAS bf16_t*)(lds + ML_N + tid * 2) = (bf16_t)f2bf(n0 ? n0[tid] : 0.f);
    __syncthreads();
    if (w == 0) {
        float mcur = m0 ? m0[0] : 0.f;
        for (int c = 0; c < nch; ++c) {
            float b = lb[64 * c + lane];
#pragma unroll
            for (int o = 1; o < 64; o <<= 1) { const float t = __shfl_up(b, o); if (lane >= o) b += t; }
            const float av = la[64 * c + lane] - b;
            float cm = av;
#pragma unroll
            for (int o = 1; o < 64; o <<= 1) { const float t = __shfl_up(cm, o); if (lane >= o) cm = fmaxf(cm, t); }
            const float g = fmaxf(mcur, cm);
            la[64 * c + lane] = av; lg[64 * c + lane] = g; lb[64 * c + lane] = b;
            if (lane == 0) lmp[c] = mcur;
            mcur = __shfl(b + g, 63);
        }
        if (lane == 0) { lmp[nch] = mcur; mout[0] = mcur; }
    }
    const int vb = w >> 1, db = w & 1, tb = w & 1;
    f32x16 Cacc;
    float nreg = n0 ? n0[32 * db + r32] : 0.f;
#pragma unroll
    for (int r = 0; r < 16; ++r) { const int dv = 32 * vb + crow(r, hi), dk = 32 * db + r32; Cacc[r] = C0 ? C0[dv * 64 + dk] : 0.f; }
#pragma unroll
    for (int r = 0; r < 16; ++r) { const int dv = 32 * vb + crow(r, hi), dk = 32 * db + r32; *(LAS bf16_t*)(lds + ML_C + rimg(dv, dk >> 3, 128) + (dk & 7) * 2) = (bf16_t)f2bf(Cacc[r]); }
    const int st = tid >> 3, sc8 = tid & 7, sv0 = tid >> 4, sc16 = tid & 15;
    u32x4 qr, kr, v0r, v1r;
    {
        const bool ok = st < ntok; const bool ok0 = sv0 < ntok, ok1 = sv0 + 32 < ntok; const u32x4 z = {0u, 0u, 0u, 0u};
        qr = ok ? *(const u32x4*)(Pb + (size_t)st * NPROJ + h * 64 + sc8 * 8) : z; kr = ok ? *(const u32x4*)(Pb + (size_t)st * NPROJ + 256 + h * 64 + sc8 * 8) : z;
        v0r = ok0 ? *(const u32x4*)(Pb + (size_t)sv0 * NPROJ + 512 + h * 128 + sc16 * 8) : z; v1r = ok1 ? *(const u32x4*)(Pb + (size_t)(sv0 + 32) * NPROJ + 512 + h * 128 + sc16 * 8) : z;
    }
    __syncthreads();
    const int vlane = ((lane >> 4) & 1) * 32 + (lane & 3) * 8 + (4 * hi + ((lane & 15) >> 2)) * 64;
    for (int c = 0; c < nch; ++c) {
        const ldsp buf = lds + (c & 1) * ML_BUFB;
        {
            const float g63 = lg[64 * c + 63];
            const float wr = __expf(la[64 * c + st] - g63);
            *(LAS u32x4*)(buf + ML_Q + rimg(st, sc8, 64)) = qr; *(LAS u32x4*)(buf + ML_K + rimg(st, sc8, 64)) = kr;
            u32x4 ks; ks.x = pk2(bflo(kr.x) * wr, bfhi(kr.x) * wr); ks.y = pk2(bflo(kr.y) * wr, bfhi(kr.y) * wr); ks.z = pk2(bflo(kr.z) * wr, bfhi(kr.z) * wr); ks.w = pk2(bflo(kr.w) * wr, bfhi(kr.w) * wr);
            *(LAS u32x4*)(buf + ML_KT + timg(st, sc8)) = ks;
            *(LAS u32x4*)(buf + ML_V + timg(sv0, sc16)) = v0r; *(LAS u32x4*)(buf + ML_V + timg(sv0 + 32, sc16)) = v1r;
        }
        __syncthreads();
        const int t = 32 * tb + r32;
        if (c + 1 < nch) {
            const bf16_t* Pn = Pb + (size_t)(64 * (c + 1)) * NPROJ;
            qr = *(const u32x4*)(Pn + (size_t)st * NPROJ + h * 64 + sc8 * 8); kr = *(const u32x4*)(Pn + (size_t)st * NPROJ + 256 + h * 64 + sc8 * 8);
            v0r = *(const u32x4*)(Pn + (size_t)sv0 * NPROJ + 512 + h * 128 + sc16 * 8); v1r = *(const u32x4*)(Pn + (size_t)(sv0 + 32) * NPROJ + 512 + h * 128 + sc16 * 8);
        }
        u32x2 ogr[4];
#pragma unroll
        for (int g4 = 0; g4 < 4; ++g4) ogr[g4] = *(const u32x2*)(Pb + (size_t)(64 * c + ((t & 63) < ntok ? t : 0)) * NPROJ + 1024 + h * 128 + 32 * vb + 8 * g4 + 4 * hi);
        const float gt = lg[64 * c + t], bt = lb[64 * c + t], mprev = lmp[c];
        f32x16 s0, s1, inter, nqa;
#pragma unroll
        for (int r = 0; r < 16; ++r) { s0[r] = 0.f; s1[r] = 0.f; inter[r] = 0.f; nqa[r] = 0.f; }
#pragma unroll
        for (int stp = 0; stp < 4; ++stp) {
            const int c8 = 2 * stp + hi;
            const bf16x8 qf = lds_frag(buf + ML_Q + rimg(t, c8, 64));
            const bf16x8 k0 = lds_frag(buf + ML_K + rimg(r32, c8, 64)), k1 = lds_frag(buf + ML_K + rimg(32 + r32, c8, 64));
            const bf16x8 cf = lds_frag(lds + ML_C + rimg(32 * vb + r32, c8, 128));
            s0 = __builtin_amdgcn_mfma_f32_32x32x16_bf16(k0, qf, s0, 0, 0, 0);
            s1 = __builtin_amdgcn_mfma_f32_32x32x16_bf16(k1, qf, s1, 0, 0, 0);
            inter = __builtin_amdgcn_mfma_f32_32x32x16_bf16(cf, qf, inter, 0, 0, 0);
            nqa = __builtin_amdgcn_mfma_f32_32x32x16_bf16(lds_frag(lds + ML_N + c8 * 16), qf, nqa, 0, 0, 0);
        }
        float dsum = 0.f;
#pragma unroll
        for (int r = 0; r < 16; ++r) {
            const int sA = crow(r, hi), sB = 32 + sA;
            const float wA = (sA <= t) ? __expf(la[64 * c + sA] - gt) : 0.f, wB = (sB <= t) ? __expf(la[64 * c + sB] - gt) : 0.f;
            s0[r] *= wA; s1[r] *= wB; dsum += s0[r] + s1[r];
        }
        dsum += __shfl_xor(dsum, 32);
        f32x16 intra;
#pragma unroll
        for (int r = 0; r < 16; ++r) intra[r] = 0.f;
        {
            const bf16x8 pf0 = pack8(s0, 0), pf1 = pack8(s0, 1), pf2 = pack8(s1, 0), pf3 = pack8(s1, 1);
            const ldsp vq = buf + ML_V + vlane + vb * 4096;
            intra = __builtin_amdgcn_mfma_f32_32x32x16_bf16(vtr2(vq), pf0, intra, 0, 0, 0);
            intra = __builtin_amdgcn_mfma_f32_32x32x16_bf16(vtr2(vq + 1024), pf1, intra, 0, 0, 0);
            intra = __builtin_amdgcn_mfma_f32_32x32x16_bf16(vtr2(vq + 2048), pf2, intra, 0, 0, 0);
            intra = __builtin_amdgcn_mfma_f32_32x32x16_bf16(vtr2(vq + 3072), pf3, intra, 0, 0, 0);
        }
        const float nq = nqa[0];
        const float winter = __expf(mprev - gt);
        float den = dsum + winter * nq;
        den = fmaxf(fabsf(den), __expf(-(bt + gt)));
        const float rden = 1.0f / den;
        float ssq = 0.f;
#pragma unroll
        for (int r = 0; r < 16; ++r) { const float hv = (intra[r] + winter * inter[r]) * rden; intra[r] = hv; ssq += hv * hv; }
        ssq += __shfl_xor(ssq, 32);
        if (hi == 0) lss[vb * 64 + t] = ssq;
        __syncthreads();
        {
            const float tot = lss[t] + lss[64 + t] + lss[128 + t] + lss[192 + t];
            const float rstd = __builtin_amdgcn_rsqf(tot * (1.0f / 128.0f) + EPS);
            if ((t & 63) < ntok) {
                const size_t rowo = (size_t)(64 * c + t);
                bf16_t* orow = Hb + rowo * D;
#pragma unroll
                for (int g4 = 0; g4 < 4; ++g4) { const int dd = 32 * vb + 8 * g4 + 4 * hi; const f32x4 gv = *(const f32x4*)(gm + dd); const u32x2 ov = ogr[g4];
                    u32x2 o; o.x = pk2(intra[4 * g4] * rstd * gv[0] * bflo(ov.x), intra[4 * g4 + 1] * rstd * gv[1] * bfhi(ov.x));
                    o.y = pk2(intra[4 * g4 + 2] * rstd * gv[2] * bflo(ov.y), intra[4 * g4 + 3] * rstd * gv[3] * bfhi(ov.y));
                    *(u32x2*)(orow + dd) = o; }
            }
        }
        {
            const float wstate = __expf(mprev - lg[64 * c + 63]);
#pragma unroll
            for (int r = 0; r < 16; ++r) Cacc[r] *= wstate;
            const ldsp vq = buf + ML_V + vlane + vb * 4096; const ldsp kq = buf + ML_KT + vlane + db * 4096;
            f32x16 nsum;
#pragma unroll
            for (int r = 0; r < 16; ++r) nsum[r] = 0.f;
            const bf16x8 ones = {0x3f80, 0x3f80, 0x3f80, 0x3f80, 0x3f80, 0x3f80, 0x3f80, 0x3f80};
#pragma unroll
            for (int ks = 0; ks < 4; ++ks) { const bf16x8 kf = vtr2(kq + ks * 1024); Cacc = __builtin_amdgcn_mfma_f32_32x32x16_bf16(vtr2(vq + ks * 1024), kf, Cacc, 0, 0, 0);
                nsum = __builtin_amdgcn_mfma_f32_32x32x16_bf16(ones, kf, nsum, 0, 0, 0); }
            nreg = nreg * wstate + nsum[0];
#pragma unroll
            for (int r = 0; r < 16; ++r) { const int dv = 32 * vb + crow(r, hi), dk = 32 * db + r32; *(LAS bf16_t*)(lds + ML_C + rimg(dv, dk >> 3, 128) + (dk & 7) * 2) = (bf16_t)f2bf(Cacc[r]); }
            if (vb == 0 && hi == 0) *(LAS bf16_t*)(lds + ML_N + (32 * db + r32) * 2) = (bf16_t)f2bf(nreg);
        }
    }
    __syncthreads();
#pragma unroll
    for (int r = 0; r < 16; ++r) { const int dv = 32 * vb + crow(r, hi), dk = 32 * db + r32; Cout[dv * 64 + dk] = Cacc[r]; }
    if (vb == 0 && hi == 0) nout[32 * db + r32] = nreg;
}

constexpr int U_ML = 128, U_AS = 32, U_AP = 2048, U_MS = 32, NUNITS = U_ML + U_AS + U_AP + U_MS;
__device__ __forceinline__ void mixer_phase(const Args& a, ldsp lds, int rep) {
    unsigned char* ws = a.ws;
    unsigned* ctr = (unsigned*)(ws + WS_CTL) + rep;
    const float lam = ((const float*)(ws + WS_CTL))[64];
    const bf16_t* P = (const bf16_t*)(ws + WS_P); bf16_t* H = (bf16_t*)(ws + WS_H);
    const float* gates = (const float*)(ws + WS_GATES);
    LAS unsigned* su = (LAS unsigned*)(lds + 131072);
    float* out = a.out;
    const int w = __builtin_amdgcn_readfirstlane(threadIdx.x >> 6);
    for (;;) {
        __syncthreads();
        if (threadIdx.x == 0) su[0] = atomicAdd(ctr, 1u);
        __syncthreads();
        int u = __builtin_amdgcn_readfirstlane((int)su[0]);
        if (u >= NUNITS) break;
        const bool is_ml = (u < U_ML) || (u >= U_ML + U_AS + U_AP);
        if (is_ml) {
            const bool samp = u >= U_ML; if (samp) u -= U_ML + U_AS + U_AP;
            const int b = u >> 2, h = u & 3;
            const size_t row0 = samp ? (size_t)(MP + 16 * b) : (size_t)b * SEQ;
            mlstm_unit(lds, P + row0 * NPROJ, gates + row0 * 8, h, samp ? 1 : 32, samp ? 16 : 64,
                       samp ? a.in[4] + (size_t)u * 8192 : nullptr, samp ? a.in[5] + u * 64 : nullptr, samp ? a.in[6] + u : nullptr,
                       H + row0 * D + h * 128, a.in[17] + h * 128,
                       out + (samp ? O_CS : O_CP) + (size_t)u * 8192, out + (samp ? O_NS : O_NP) + u * 64, out + (samp ? O_MS : O_MPR) + u);
        } else {
            u -= U_ML;
            const bool samp = u < U_AS; if (!samp) u -= U_AS;
            const int qb = samp ? 0 : 15 - (u >> 7), bh = samp ? u : (u & 127), b = bh >> 2, h = bh & 3;
            const size_t qrow0 = samp ? (size_t)(MP + 16 * b) : (size_t)b * SEQ + 128 * qb;
            const bf16_t* Kg = samp ? (const bf16_t*)(ws + WS_SK) + (size_t)b * 1088 * 512 + h * 128 : P + (size_t)b * SEQ * NPROJ + 2048 + h * 128;
            const bf16_t* Vg = samp ? (const bf16_t*)(ws + WS_SV) + (size_t)b * 1088 * 512 + h * 128 : P + (size_t)b * SEQ * NPROJ + 2560 + h * 128;
            const int lim = samp ? ((w >> 1) == 0 ? 16 : -1) : 2 * qb + (w >> 2);
            attn_unit(lds, P + qrow0 * NPROJ + 1536 + h * 128, NPROJ, samp ? 16 : 128, Kg, Vg, samp ? 512 : NPROJ, samp ? 17 : 2 * qb + 2, lim, samp ? 16 : 64,
                      H + qrow0 * D + 512 + h * 128, a.in[18] + h * 128, lam);
        }
    }
}

template <int MODE, int SB  , int NB  >
__device__ __forceinline__ void mini_gemm(ldsp lds, const bf16_t* A, const bf16_t* Bt, int K, int ntn, bf16_t* O, const Args& a) {
    int tid = threadIdx.x; asm volatile("" : "+v"(tid));
    const int lane = tid & 63, w = __builtin_amdgcn_readfirstlane(tid >> 6), r32 = lane & 31, hi = lane >> 5;
    LAS float* red = (LAS float*)lds;
    unsigned char* ws = a.ws;
    for (int task = blockIdx.x; task < 4 * ntn; task += gridDim.x) {
        const int mt = task / ntn, nt = task % ntn;
        const int wrow0 = (MODE == 1) ? (256 * (nt >> 2) + 32 * (nt & 3)) : 32 * nt;
        const bf16_t* ap = A + (size_t)(32 * mt + r32) * K + (size_t)w * (SB * NB * 16) + 8 * hi;
        const bf16_t* bp = Bt + (size_t)(wrow0 + r32) * K + (size_t)w * (SB * NB * 16) + 8 * hi;
        f32x16 acc0, acc1;
#pragma unroll
        for (int r = 0; r < 16; ++r) { acc0[r] = 0.f; acc1[r] = 0.f; }
#pragma unroll 1
        for (int nb = 0; nb < NB; ++nb) {
            bf16x8 af[SB], b0[SB], b1[SB];
#pragma unroll
            for (int i = 0; i < SB; ++i) { af[i] = *(const bf16x8*)(ap + (nb * SB + i) * 16); b0[i] = *(const bf16x8*)(bp + (nb * SB + i) * 16);
                if (MODE == 1) b1[i] = *(const bf16x8*)(bp + (size_t)128 * K + (nb * SB + i) * 16); }
#pragma unroll
            for (int i = 0; i < SB; ++i) { acc0 = __builtin_amdgcn_mfma_f32_32x32x16_bf16(b0[i], af[i], acc0, 0, 0, 0);
                if (MODE == 1) acc1 = __builtin_amdgcn_mfma_f32_32x32x16_bf16(b1[i], af[i], acc1, 0, 0, 0); }
        }
#pragma unroll
        for (int r = 0; r < 16; ++r) { red[((w * 2 + 0) * 16 + r) * 64 + lane] = acc0[r]; if (MODE == 1) red[((w * 2 + 1) * 16 + r) * 64 + lane] = acc1[r]; }
        __syncthreads();
        {
            LAS float* fin = (LAS float*)(lds + 65536);
#pragma unroll
            for (int rr = 0; rr < 2; ++rr) { const int r = 2 * w + rr; float s0 = 0.f, s1 = 0.f;
#pragma unroll
                for (int k = 0; k < 8; ++k) { s0 += red[((k * 2 + 0) * 16 + r) * 64 + lane]; if (MODE == 1) s1 += red[((k * 2 + 1) * 16 + r) * 64 + lane]; }
                fin[r * 64 + lane] = s0; if (MODE == 1) fin[(16 + r) * 64 + lane] = s1; }
        }
        __syncthreads();
        if (w == 0) {
            const LAS float* fin = (const LAS float*)(lds + 65536);
#pragma unroll
            for (int r = 0; r < 16; ++r) { acc0[r] = fin[r * 64 + lane]; acc1[r] = (MODE == 1) ? fin[(16 + r) * 64 + lane] : 0.f; }
            const int srow = 32 * mt + r32;
            if (MODE == 0) {
                bf16_t* o = O + (size_t)srow * D + 32 * nt;
#pragma unroll
                for (int g = 0; g < 4; ++g) { u32x2 v; v.x = pk2(acc0[4 * g], acc0[4 * g + 1]); v.y = pk2(acc0[4 * g + 2], acc0[4 * g + 3]); *(u32x2*)(o + 8 * g + 4 * hi) = v; }
            } else if (MODE == 1) {
                bf16_t* o = O + (size_t)srow * FF + 32 * nt;
#pragma unroll
                for (int r = 0; r < 16; ++r) acc0[r] = acc0[r] * pg8::fast_sigmoid(acc0[r]) * acc1[r];
#pragma unroll
                for (int g = 0; g < 4; ++g) { u32x2 v; v.x = pk2(acc0[4 * g], acc0[4 * g + 1]); v.y = pk2(acc0[4 * g + 2], acc0[4 * g + 3]); *(u32x2*)(o + 8 * g + 4 * hi) = v; }
            } else {
                const int col0 = 32 * nt, pn = col0 >> 8;
                const int type = (pn == 0) ? 0 : (pn == 1) ? 1 : (pn < 4) ? 2 : (pn < 6) ? 3 : (pn < 8) ? 4 : (pn < 10) ? 5 : 6;
                if (type == 1) {
#pragma unroll
                    for (int r = 0; r < 16; ++r) acc0[r] *= 0.125f;
                } else if (type == 3) {
#pragma unroll
                    for (int r = 0; r < 16; ++r) acc0[r] = pg8::fast_sigmoid(acc0[r]);
                } else if ((type == 4 || type == 5) && (col0 & 63) == 0) {
                    const float* t = (const float*)(ws + WS_ROPE) + (1024 + (srow & 15)) * 16 + 4 * hi;
                    const f32x4 cs = *(const f32x4*)t, sn = *(const f32x4*)(t + 8);
#pragma unroll
                    for (int j = 0; j < 4; ++j) { const float x1 = acc0[j], x2 = acc0[4 + j]; acc0[j] = x1 * cs[j] - x2 * sn[j]; acc0[4 + j] = x2 * cs[j] + x1 * sn[j]; }
                }
                if (type >= 5) {
                    const int c512 = col0 - (type == 5 ? 2048 : 2560);
                    float* o = a.out + (type == 5 ? O_KS : O_VS) + (size_t)srow * 512 + c512;
#pragma unroll
                    for (int g = 0; g < 4; ++g) *(f32x4*)(o + 8 * g + 4 * hi) = (f32x4){acc0[4 * g], acc0[4 * g + 1], acc0[4 * g + 2], acc0[4 * g + 3]};
                }
                if (type == 4) {
#pragma unroll
                    for (int r = 0; r < 16; ++r) acc0[r] *= (0.125f * 1.4426950408889634f);
                }
                bf16_t* o = O + (size_t)srow * NPROJ + col0;
                bf16_t* o2 = (bf16_t*)(ws + (type == 5 ? WS_SK : WS_SV)) + ((size_t)((srow >> 4) * 1088 + 1024 + (srow & 15)) * 512 + (col0 - (type == 5 ? 2048 : 2560)));
#pragma unroll
                for (int g = 0; g < 4; ++g) { u32x2 v; v.x = pk2(acc0[4 * g], acc0[4 * g + 1]); v.y = pk2(acc0[4 * g + 2], acc0[4 * g + 3]); *(u32x2*)(o + 8 * g + 4 * hi) = v;
                    if (type >= 5) *(u32x2*)(o2 + 8 * g + 4 * hi) = v; }
            }
        }
        __syncthreads();
    }
}

#define XB_TMO      128
#define XB_XCNT(j)  (256  + 64 * (j))
#define XB_XSUB(j)  (1280 + 64 * (j))
#define XB_XGEN(j)  (2304 + 64 * (j))
#define XB_TOP      3328
#define XB_TOPGEN   3392
#define XCD_BAR_WORDS 3456
#define XB_SPIN_CAP (1u << 22)

__device__ __forceinline__ unsigned xb_ld(unsigned* p)              { return __hip_atomic_load(p, __ATOMIC_RELAXED, __HIP_MEMORY_SCOPE_AGENT); }
__device__ __forceinline__ unsigned xb_add(unsigned* p, unsigned v) { return __hip_atomic_fetch_add(p, v, __ATOMIC_RELAXED, __HIP_MEMORY_SCOPE_AGENT); }
__device__ __forceinline__ unsigned xb_xcc_id() { return (unsigned)__builtin_amdgcn_s_getreg((3 << 11) | 20) & 0xFu; }
#define XB_SPIN(cond, bar) do { unsigned _sp = 0; while (cond) { __builtin_amdgcn_s_sleep(1); \
    if ((++_sp & 255u) == 0u) { if (xb_ld(&(bar)[XB_TMO])) break; if (_sp > XB_SPIN_CAP) { atomicAdd(&(bar)[XB_TMO], 1u); break; } } } } while (0)

struct XcdBarrier {
    unsigned* bar; unsigned x;
    volatile LAS unsigned* st;
};

__device__ __forceinline__ XcdBarrier xcd_barrier_post(unsigned* bar, volatile LAS unsigned* st) {
    XcdBarrier b; b.bar = bar; b.x = xb_xcc_id(); b.st = st;
    if (threadIdx.x == 0) (void)xb_add(&bar[XB_XCNT(b.x)], 1u);
    return b;
}
__device__ __forceinline__ void xcd_barrier_complete(unsigned* bar, unsigned x, unsigned& nloc, unsigned& nx) {
    const unsigned G = gridDim.x * gridDim.y * gridDim.z;
    unsigned sum, cnt, mine, sp = 0u;
    for (;;) {
        sum = 0u; cnt = 0u; mine = 0u;
#pragma unroll
        for (unsigned j = 0; j < 16; ++j) { const unsigned c = xb_ld(&bar[XB_XCNT(j)]); sum += c; cnt += (c > 0u) ? 1u : 0u; mine = (j == x) ? c : mine; }
        if (sum == G) break;
        __builtin_amdgcn_s_sleep(1);
        if ((++sp & 255u) == 0u) { if (xb_ld(&bar[XB_TMO])) break; if (sp > XB_SPIN_CAP) { atomicAdd(&bar[XB_TMO], 1u); break; } }
    }
    nloc = mine > 0u ? mine : 1u; nx = cnt > 0u ? cnt : 1u;
}

__device__ __forceinline__ void xcd_barrier(const XcdBarrier& b) {
    asm volatile("s_waitcnt vmcnt(0)" ::: "memory");
    __syncthreads();
    if (threadIdx.x == 0) {
        unsigned* bar = b.bar;
        __builtin_amdgcn_s_waitcnt(0);
        unsigned nloc = b.st[0], nx = b.st[1];
        if (nloc == 0u) { xcd_barrier_complete(bar, b.x, nloc, nx); b.st[0] = nloc; b.st[1] = nx; }
        const unsigned old = xb_add(&bar[XB_XSUB(b.x)], 1u);
        const unsigned gen = old / nloc;
        if (old + 1u == (gen + 1u) * nloc) {
            __builtin_amdgcn_fence(__ATOMIC_RELEASE, "agent");
            asm volatile("s_waitcnt vmcnt(0)" ::: "memory");
            const unsigned og = xb_add(&bar[XB_TOP], 1u);
            const unsigned tg = og / nx;
            if (og + 1u == (tg + 1u) * nx) xb_add(&bar[XB_TOPGEN], 1u);
            else XB_SPIN(xb_ld(&bar[XB_TOPGEN]) == tg, bar);
            __builtin_amdgcn_fence(__ATOMIC_ACQUIRE, "agent");
            xb_add(&bar[XB_XGEN(b.x)], 1u);
            asm volatile("s_waitcnt vmcnt(0)" ::: "memory");
        } else {
            XB_SPIN(xb_ld(&bar[XB_XGEN(b.x)]) == gen, bar);
            __builtin_amdgcn_fence(__ATOMIC_ACQUIRE, "agent");
            asm volatile("s_waitcnt vmcnt(0)" ::: "memory");
        }
    }
    __syncthreads();
}

constexpr int NPHASE = 12;
#ifndef REP_MASK
#define REP_MASK 0
#endif
template <bool COOP>
__global__ void __launch_bounds__(NTHR, 2) mega(Args a) {
    extern __shared__ __attribute__((aligned(16))) unsigned char lds_raw[];
    ldsp lds = (ldsp)lds_raw;
    unsigned char* ws = a.ws;
    const int lo = a.ph_lo, hi = a.ph_hi, G = gridDim.x, bx = blockIdx.x;
#define IN(k) (lo <= (k) && (k) < hi)
    XcdBarrier bar; bar.bar = (unsigned*)(ws + WS_CTL) + 4096; bar.x = 0; bar.st = nullptr;
    if (COOP) {
        volatile LAS unsigned* misc = (volatile LAS unsigned*)(lds + 131072 + 64);
        if (threadIdx.x < 2) misc[threadIdx.x] = 0u;
        __syncthreads();
        bar = xcd_barrier_post((unsigned*)(ws + WS_CTL) + 4096, misc);
    }
#define SEAM(k) do { if (COOP) { if (IN(k) && IN((k) + 1)) { if ((k) == 0) cg::this_grid().sync(); else xcd_barrier(bar); } } } while (0)
    bf16_t* H = (bf16_t*)(ws + WS_H); bf16_t* F = (bf16_t*)(ws + WS_F); bf16_t* P = (bf16_t*)(ws + WS_P);
    float* X = a.out + O_Y;
    if (IN(0)) { for (int rep = 0; rep < 1 + ((REP_MASK >> 0) & 1); ++rep) { if (rep) { if (COOP) xcd_barrier(bar); } p0_prologue(a, lds); } } SEAM(0);
    if (IN(1)) { for (int rep = 0; rep < 1 + ((REP_MASK >> 1) & 1); ++rep) { if (rep) { if (COOP) xcd_barrier(bar); } row_phase<false, true, false>(a, lds, a.in[0], a.in[1], nullptr, 0, 0.f, 0, 0, 0, 1); } } SEAM(1);
    if (IN(2)) { for (int rep = 0; rep < 1 + ((REP_MASK >> 2) & 1); ++rep) { if (rep) { if (COOP) xcd_barrier(bar); } pg8::Gemm g{H, (const bf16_t*)(ws + WS_W1I), MP, 2 * FF, D}; pg8::StaticOrder S; S.init(MP, 2 * FF, G, bx); pg8::EpiSwiglu E{P, FF, 1.0f};
        pg8::gemm_phase<pg8::EpiSwiglu, pg8::StaticOrder, true, true>(lds, g, S, E);
        mini_gemm<1, 8, 1>(lds, H + (size_t)MP * D, (const bf16_t*)(ws + WS_W1I), D, FF / 32, P + (size_t)MP * FF, a); } } SEAM(2);
    if (IN(3)) { for (int rep = 0; rep < 1 + ((REP_MASK >> 3) & 1); ++rep) { if (rep) { if (COOP) xcd_barrier(bar); } pg8::Gemm g{P, (const bf16_t*)(ws + WS_W1O), MP, D, FF}; pg8::StaticOrder S; S.init(MP, D, G, bx); pg8::EpiPlain E{F, D, 1.0f};
        pg8::gemm_phase<pg8::EpiPlain, pg8::StaticOrder, true, true>(lds, g, S, E);
        mini_gemm<0, 11, 2>(lds, P + (size_t)MP * FF, (const bf16_t*)(ws + WS_W1O), FF, D / 32, F + (size_t)MP * D, a); } } SEAM(3);
    if (IN(4)) { for (int rep = 0; rep < 1 + ((REP_MASK >> 4) & 1); ++rep) { if (rep) { if (COOP) xcd_barrier(bar); } row_phase<true, true, true, false, false, true>(a, lds, a.in[0], a.in[1], X, 2, 0.5f, 1, 2, 3, 4); } } SEAM(4);
    if (IN(5)) { for (int rep = 0; rep < 1 + ((REP_MASK >> 5) & 1); ++rep) { if (rep) { if (COOP) xcd_barrier(bar); } pg8::Gemm g{H, (const bf16_t*)(ws + WS_WIN), MP, NPROJ, D}; pg8::StaticOrder S; S.init(MP, NPROJ, G, bx);
        pg8::EpiProj E{P, (bf16_t*)(ws + WS_SK), (bf16_t*)(ws + WS_SV), a.out + O_KP, a.out + O_VP, a.out + O_KS, a.out + O_VS, (const float*)(ws + WS_ROPE)};
        pg8::gemm_phase<pg8::EpiProj, pg8::StaticOrder, true, true>(lds, g, S, E);
        mini_gemm<2, 8, 1>(lds, H + (size_t)MP * D, (const bf16_t*)(ws + WS_WIN), D, NPROJ / 32, P + (size_t)MP * NPROJ, a); } } SEAM(5);
    if (IN(6)) { for (int rep = 0; rep < 1 + ((REP_MASK >> 6) & 1); ++rep) { if (rep) { if (COOP) xcd_barrier(bar); } mixer_phase(a, lds, rep); } } SEAM(6);
    if (IN(7)) { for (int rep = 0; rep < 1 + ((REP_MASK >> 7) & 1); ++rep) { if (rep) { if (COOP) xcd_barrier(bar); } pg8::Gemm g{H, (const bf16_t*)(ws + WS_WO), MP, D, D}; pg8::StaticOrder S; S.init(MP, D, G, bx); pg8::EpiPlain E{F, D, 1.0f};
        pg8::gemm_phase<pg8::EpiPlain, pg8::StaticOrder, true, true>(lds, g, S, E);
        mini_gemm<0, 8, 1>(lds, H + (size_t)MP * D, (const bf16_t*)(ws + WS_WO), D, D / 32, F + (size_t)MP * D, a); } } SEAM(7);
    if (IN(8)) { for (int rep = 0; rep < 1 + ((REP_MASK >> 8) & 1); ++rep) { if (rep) { if (COOP) xcd_barrier(bar); } row_phase<true, true, false, true, true, true>(a, lds, X, X + (size_t)MP * D, X, 5, 1.0f, 3, 4, 6, 7); } } SEAM(8);
    if (IN(9)) { for (int rep = 0; rep < 1 + ((REP_MASK >> 9) & 1); ++rep) { if (rep) { if (COOP) xcd_barrier(bar); } pg8::Gemm g{H, (const bf16_t*)(ws + WS_W2I8), MP, 2 * FF, D / 2}; pg8::StaticOrder S; S.init(MP, 2 * FF, G, bx); pg8::EpiSwigluF8 E{(unsigned char*)P, FF, 1.0f / (H8_SCALE * W8_SCALE), A8_SCALE};
        pg8::gemm_phase<pg8::EpiSwigluF8, pg8::StaticOrder, true, true, true>(lds, g, S, E);
        mini_gemm<1, 8, 1>(lds, H + (size_t)MP * D, (const bf16_t*)(ws + WS_W2I), D, FF / 32, P + (size_t)MP * FF, a); } } SEAM(9);
    if (IN(10)) { for (int rep = 0; rep < 1 + ((REP_MASK >> 10) & 1); ++rep) { if (rep) { if (COOP) xcd_barrier(bar); } pg8::Gemm g{P, (const bf16_t*)(ws + WS_W2O8), MP, D, FF / 2}; pg8::StaticOrder S; S.init(MP, D, G, bx); pg8::EpiPlain E{F, D, 1.0f / (A8_SCALE * W8_SCALE)};
        pg8::gemm_phase<pg8::EpiPlain, pg8::StaticOrder, true, true, true>(lds, g, S, E);
        mini_gemm<0, 11, 2>(lds, P + (size_t)MP * FF, (const bf16_t*)(ws + WS_W2O), FF, D / 32, F + (size_t)MP * D, a); } } SEAM(10);
    if (IN(11)) { for (int rep = 0; rep < 1 + ((REP_MASK >> 11) & 1); ++rep) { if (rep) { if (COOP) xcd_barrier(bar); } row_phase<true, false, false, false, true, false>(a, lds, X, X + (size_t)MP * D, X, 8, 0.5f, 5, 0, 0, 0); } }
#undef IN
#undef SEAM
}

#ifndef MK_LAUNCHES
#define MK_LAUNCHES 1
#endif
extern "C" void kernel_launch(void* const* d_in, const int* in_sizes, int n_in, void* d_out, int out_size, void* d_ws, size_t ws_size, hipStream_t stream) {
    static int grid = 0;
    if (grid == 0) {
        if (n_in != 23 || (size_t)out_size != O_END || ws_size < WS_END) { fprintf(stderr, "kernel_launch: unexpected shapes (n_in %d, out %d, ws %zu)\n", n_in, out_size, ws_size); grid = -1; return; }
        int dev = 0, cus = 0, per_cu = 0;
        hipGetDevice(&dev); hipDeviceGetAttribute(&cus, hipDeviceAttributeMultiprocessorCount, dev);
        hipFuncSetAttribute((const void*)mega<true>, hipFuncAttributeMaxDynamicSharedMemorySize, LDS_BYTES);
        hipFuncSetAttribute((const void*)mega<false>, hipFuncAttributeMaxDynamicSharedMemorySize, LDS_BYTES);
        hipOccupancyMaxActiveBlocksPerMultiprocessor(&per_cu, (const void*)mega<true>, NTHR, LDS_BYTES);
        if (per_cu < 1) per_cu = 1;
        (void)hipGetLastError();
        grid = cus * per_cu;
    }
    if (grid < 0) return;
    if (hipMemsetAsync(d_ws, 0, 65536, stream) != hipSuccess) { fprintf(stderr, "kernel_launch: memset failed\n"); return; }
    Args a{};
    for (int i = 0; i < 23; ++i) a.in[i] = (const float*)d_in[i];
    a.out = (float*)d_out; a.ws = (unsigned char*)d_ws;
    if (MK_LAUNCHES == 1) {
        a.ph_lo = 0; a.ph_hi = NPHASE;
        void* args[] = {&a};
        hipError_t e = hipLaunchCooperativeKernel((const void*)mega<true>, dim3(grid), dim3(NTHR), args, LDS_BYTES, stream);
        if (e != hipSuccess) fprintf(stderr, "cooperative launch failed: %s (grid %d)\n", hipGetErrorString(e), grid);
    } else {
        for (int p = 0; p < NPHASE; ++p) { a.ph_lo = p; a.ph_hi = p + 1; hipLaunchKernelGGL(mega<false>, dim3(grid), dim3(NTHR), LDS_BYTES, stream, a); }
    }
}
```

```cpp
#include <hip/hip_runtime.h>
#include <hip/hip_cooperative_groups.h>
#include <cstdio>
#include <cstdint>
#include <cmath>
namespace pg8 {
#define PG8_LAS __attribute__((address_space(3)))
typedef unsigned short bf16_t;
typedef short bf16x8 __attribute__((ext_vector_type(8)));
typedef float f32x4 __attribute__((ext_vector_type(4)));
typedef unsigned u32x4 __attribute__((ext_vector_type(4)));
typedef int v8i32 __attribute__((ext_vector_type(8)));
typedef int v4i32 __attribute__((ext_vector_type(4)));
constexpr int BM = 256, BK = 64, HALF = 128, HTB = HALF * BK * 2  , STAGE_BYTES = 8 * HTB, NXCD = 8, WGM = 8;

__host__ __device__ __forceinline__ int lds_byte(int r, int c) { const int st = (r >> 4) * 2 + (c >> 5), rr = r & 15, cc = c & 31, ob = rr * 64 + cc * 2; return st * 1024 + (ob ^ (((ob >> 9) & 1) << 5)); }
__host__ __device__ __forceinline__ void stage_rc(int b, int& R, int& C) { const int st = b / 1024, sb = b % 1024, swz = sb ^ (((sb >> 9) & 1) << 5); R = (st >> 1) * 16 + swz / 64; C = (st & 1) * 32 + (swz % 64) / 2; }
__host__ __device__ __forceinline__ int perm32(int rho) { const int n = rho >> 4, i = rho & 15; return 8 * (i >> 2) + 4 * n + (i & 3); }

struct Unit { int pm, pn; };
struct Gemm { const bf16_t* A; const bf16_t* Bt; int M, N, K; };

struct StaticOrder {
    int nM, nN, nwg, G, c;
    __host__ __device__ void init(int M, int N, int G_, int c_) { nM = M / BM; nN = N / BM; nwg = nM * nN; G = G_; c = c_; }
    __host__ __device__ bool next(int i, Unit& u) const {
        const long L = (long)i * G + c; if (L >= nwg) return false;
        int wgid = (int)L; { const int q = nwg / NXCD, r = nwg % NXCD, xcd = wgid % NXCD, off = wgid / NXCD; wgid = (xcd < r ? xcd * (q + 1) : r * (q + 1) + (xcd - r) * q) + off; }
        const int nig = WGM * nN, gid = wgid / nig, fm = gid * WGM, gsz = (nM - fm) < WGM ? (nM - fm) : WGM;
        u.pm = fm + ((wgid % nig) % gsz); u.pn = (wgid % nig) / gsz; return true;
    }
    __device__ __forceinline__ void a_ready(const Unit&) const {}
    __device__ __forceinline__ void done(const Unit&) const {}
};
__device__ __forceinline__ unsigned cvt_pk_bf16(float lo, float hi) { unsigned r; asm volatile("v_cvt_pk_bf16_f32 %0, %1, %2" : "=v"(r) : "v"(lo), "v"(hi)); return r; }
typedef float f32x2 __attribute__((ext_vector_type(2)));
typedef unsigned u32x4 __attribute__((ext_vector_type(4)));
constexpr int E_MP = 65536, E_MV = 65664;
__device__ __forceinline__ float fast_sigmoid(float x) { return __builtin_amdgcn_rcpf(1.0f + __expf(-x)); }
struct EpiSwiglu {
    static constexpr bool PERM = true, AFTER_DRAIN = false;
    bf16_t* O; int ldo; float sc;
    __device__ __forceinline__ void operator()(const f32x4 (&acc)[2][2][4][2], const Unit& u, int wr, int wc, int fr, int fq) const {
        const int row0 = u.pm * BM + wr * 64 + fr, col0 = u.pn * 128 + wc * 32 + 8 * fq;
#pragma unroll
        for (int ai = 0; ai < 2; ++ai)
#pragma unroll
            for (int m = 0; m < 4; ++m) {
                bf16_t* p = O + (size_t)(row0 + ai * HALF + m * 16) * ldo + col0;
                const f32x4 g0 = acc[ai][0][m][0] * sc, g1 = acc[ai][0][m][1] * sc, u0 = acc[ai][1][m][0] * sc, u1 = acc[ai][1][m][1] * sc;
                f32x4 a0, a1;
#pragma unroll
                for (int j = 0; j < 4; ++j) { a0[j] = g0[j] * fast_sigmoid(g0[j]) * u0[j]; a1[j] = g1[j] * fast_sigmoid(g1[j]) * u1[j]; }
                u32x4 w; w.x = cvt_pk_bf16(a0[0], a0[1]); w.y = cvt_pk_bf16(a0[2], a0[3]); w.z = cvt_pk_bf16(a1[0], a1[1]); w.w = cvt_pk_bf16(a1[2], a1[3]);
                *(u32x4*)p = w;
            }
    }
};
struct EpiSwiglu8 {
    static constexpr bool PERM = false, AFTER_DRAIN = false;
    bf16_t* O; int ldo; float sc;
    __device__ __forceinline__ void operator()(const f32x4 (&acc)[2][2][4][2], const Unit& u, int wr, int wc, int fr, int fq) const {
        typedef unsigned u32x2e __attribute__((ext_vector_type(2)));
        const int row0 = u.pm * BM + wr * 64 + fr, col0 = u.pn * 128 + wc * 32 + 4 * fq;
#pragma unroll
        for (int ai = 0; ai < 2; ++ai)
#pragma unroll
            for (int m = 0; m < 4; ++m) {
                bf16_t* p = O + (size_t)(row0 + ai * HALF + m * 16) * ldo + col0;
#pragma unroll
                for (int n = 0; n < 2; ++n) {
                    const f32x4 g = acc[ai][0][m][n] * sc, up = acc[ai][1][m][n] * sc;
                    f32x4 a0;
#pragma unroll
                    for (int j = 0; j < 4; ++j) a0[j] = g[j] * fast_sigmoid(g[j]) * up[j];
                    u32x2e w; w.x = cvt_pk_bf16(a0[0], a0[1]); w.y = cvt_pk_bf16(a0[2], a0[3]);
                    *(u32x2e*)(p + 16 * n) = w;
                }
            }
    }
};
struct EpiSwigluF8 {
    static constexpr bool PERM = false, AFTER_DRAIN = false;
    unsigned char* O; int ldo; float sc, so;
    __device__ __forceinline__ void operator()(const f32x4 (&acc)[2][2][4][2], const Unit& u, int wr, int wc, int fr, int fq) const {
        const int row0 = u.pm * BM + wr * 64 + fr, col0 = u.pn * 128 + wc * 32 + 4 * fq;
#pragma unroll
        for (int ai = 0; ai < 2; ++ai)
#pragma unroll
            for (int m = 0; m < 4; ++m) {
                unsigned char* p = O + (size_t)(row0 + ai * HALF + m * 16) * ldo + col0;
#pragma unroll
                for (int n = 0; n < 2; ++n) {
                    const f32x4 g = acc[ai][0][m][n] * sc, up = acc[ai][1][m][n] * sc;
                    f32x4 a0;
#pragma unroll
                    for (int j = 0; j < 4; ++j) a0[j] = g[j] * fast_sigmoid(g[j]) * up[j] * so;
                    unsigned q = 0u;
                    q = __builtin_amdgcn_cvt_pk_fp8_f32(a0[0], a0[1], q, false); q = __builtin_amdgcn_cvt_pk_fp8_f32(a0[2], a0[3], q, true);
                    *(unsigned*)(p + 16 * n) = q;
                }
            }
    }
};
struct EpiPlain {
    static constexpr bool PERM = true, AFTER_DRAIN = false;
    bf16_t* O; int ldo; float sc;
    __device__ __forceinline__ void operator()(const f32x4 (&acc)[2][2][4][2], const Unit& u, int wr, int wc, int fr, int fq) const {
        const int row0 = u.pm * BM + wr * 64 + fr, col0 = u.pn * BM + wc * 32 + 8 * fq;
#pragma unroll
        for (int ai = 0; ai < 2; ++ai)
#pragma unroll
            for (int m = 0; m < 4; ++m) {
                bf16_t* p = O + (size_t)(row0 + ai * HALF + m * 16) * ldo + col0;
#pragma unroll
                for (int bj = 0; bj < 2; ++bj) {
                    const f32x4 v0 = acc[ai][bj][m][0] * sc, v1 = acc[ai][bj][m][1] * sc;
                    u32x4 w; w.x = cvt_pk_bf16(v0[0], v0[1]); w.y = cvt_pk_bf16(v0[2], v0[3]); w.z = cvt_pk_bf16(v1[0], v1[1]); w.w = cvt_pk_bf16(v1[2], v1[3]);
                    *(u32x4*)(p + bj * HALF) = w;
                }
            }
    }
};
struct EpiProj {
    static constexpr bool PERM = true, AFTER_DRAIN = false;
    bf16_t* P; bf16_t* SK; bf16_t* SV; float* okp; float* ovp; float* oks; float* ovs; const float* rope;
    __device__ __forceinline__ void operator()(const f32x4 (&acc)[2][2][4][2], const Unit& u, int wr, int wc, int fr, int fq) const {
        const int pn = u.pn;
        const int type = (pn == 0) ? 0 : (pn == 1) ? 1 : (pn < 4) ? 2 : (pn < 6) ? 3 : (pn < 8) ? 4 : (pn < 10) ? 5 : 6;
        const bool rot = (type == 4 || type == 5) && ((wc & 1) == 0);
        f32x4 ncs0 = {1.f, 1.f, 1.f, 1.f}, ncs1 = ncs0, nsn0 = {0.f, 0.f, 0.f, 0.f}, nsn1 = nsn0;
        if (rot) { const float* t = rope + ((u.pm * BM + wr * 64 + fr) & 2047) * 16; ncs0 = *(const f32x4*)t; ncs1 = *(const f32x4*)(t + 4); nsn0 = *(const f32x4*)(t + 8); nsn1 = *(const f32x4*)(t + 12); }
#pragma unroll
        for (int ai = 0; ai < 2; ++ai)
#pragma unroll
            for (int m = 0; m < 4; ++m) {
                const int row = u.pm * BM + ai * HALF + wr * 64 + m * 16 + fr;
                const bool samp = row >= E_MP, valid = row < E_MV;
                const f32x4 cs0 = ncs0, cs1 = ncs1, sn0 = nsn0, sn1 = nsn1;
                if (rot && (ai * 4 + m) < 7) { const int it = ai * 4 + m + 1; const float* t = rope + ((u.pm * BM + (it >> 2) * HALF + wr * 64 + (it & 3) * 16 + fr) & 2047) * 16;
                    ncs0 = *(const f32x4*)t; ncs1 = *(const f32x4*)(t + 4); nsn0 = *(const f32x4*)(t + 8); nsn1 = *(const f32x4*)(t + 12); }
#pragma unroll
                for (int bj = 0; bj < 2; ++bj) {
                    f32x4 v0 = acc[ai][bj][m][0], v1 = acc[ai][bj][m][1];
                    if (type == 1) { v0 = v0 * 0.125f; v1 = v1 * 0.125f; }
                    else if (type == 3) {
#pragma unroll
                        for (int j = 0; j < 4; ++j) { v0[j] = fast_sigmoid(v0[j]); v1[j] = fast_sigmoid(v1[j]); }
                    } else if (rot) {
                        f32x4 p0, p1;
#pragma unroll
                        for (int j = 0; j < 4; ++j) { p0[j] = __shfl_xor(v0[j], 16); p1[j] = __shfl_xor(v1[j], 16); }
                        if (fq == 0) { v0 = v0 * cs0 - p0 * sn0; v1 = v1 * cs1 - p1 * sn1; }
                        else if (fq == 1) { v0 = v0 * cs0 + p0 * sn0; v1 = v1 * cs1 + p1 * sn1; }
                    }
                    const int c512 = (pn & 1) * 256 + bj * HALF + wc * 32 + 8 * fq;
                    if (type >= 5 && valid) {
                        float* o = samp ? ((type == 5 ? oks : ovs) + (size_t)(row - E_MP) * 512 + c512) : ((type == 5 ? okp : ovp) + (size_t)row * 512 + c512);
                        *(f32x4*)o = v0; *(f32x4*)(o + 4) = v1;
                    }
                    if (type == 4) { v0 = v0 * (0.125f * 1.4426950408889634f); v1 = v1 * (0.125f * 1.4426950408889634f); }
                    u32x4 w; w.x = cvt_pk_bf16(v0[0], v0[1]); w.y = cvt_pk_bf16(v0[2], v0[3]); w.z = cvt_pk_bf16(v1[0], v1[1]); w.w = cvt_pk_bf16(v1[2], v1[3]);
                    *(u32x4*)(P + (size_t)row * 3072 + pn * BM + bj * HALF + wc * 32 + 8 * fq) = w;
                    if (type >= 5 && samp && valid) {
                        const int s = row - E_MP;
                        bf16_t* d = (type == 5 ? SK : SV) + ((size_t)((s >> 4) * 1088 + 1024 + (s & 15)) * 512 + c512);
                        *(u32x4*)d = w;
                    }
                }
            }
    }
};
template <class Epi, class Sched, bool ALIGN_EPI = false, bool SP2 = false, bool F8 = false  >
__device__ __forceinline__ void gemm_phase(PG8_LAS unsigned char* lds, const Gemm g, const Sched& S, const Epi& E) {
    int tid = threadIdx.x; asm volatile("" : "+v"(tid));
    const int wid = __builtin_amdgcn_readfirstlane(tid >> 6), lane = tid & 63, wr = wid >> 2, wc = wid & 3, fr = lane & 15, fq = lane >> 4;
    const int K = g.K, nt = K / BK;
    unsigned voffA[2], voffB[2];
    { int R, C; stage_rc(tid * 16, R, C); const int Rb = Epi::PERM ? ((R & ~31) + perm32(R & 31)) : R;
        voffA[0] = (unsigned)(R * K + C) * 2u; voffB[0] = (unsigned)(Rb * K + C) * 2u; voffA[1] = voffA[0] + (unsigned)(64 * K) * 2u; voffB[1] = voffB[0] + (unsigned)(64 * K) * 2u; }
    const size_t kstep = (size_t)(BK * 2);
    const size_t hstep = (size_t)HALF * K * 2;
    const size_t tstep = 2 * hstep;
    const unsigned ldsbase = (unsigned)(uintptr_t)lds; const size_t r64step = (size_t)(64 * K) * 2u;
    const unsigned ldsw = (unsigned)wid * 1024u;
    const int aoff = lds_byte(wr * 64 + fr, fq * 8), boff = lds_byte(wc * 32 + fr, fq * 8);
#define PG8_SA(b, h) (((b) * 2 + (h)) * HTB)
#define PG8_SB(b, h) ((4 + (b) * 2 + (h)) * HTB)
#define PG8_GLDS(vo, gp, ld) do { unsigned _keep; asm volatile("s_mov_b32 %0, m0\n\ts_mov_b32 m0, %3\n\ts_nop 0\n\tglobal_load_lds_dwordx4 %1, %2\n\ts_mov_b32 m0, %0" : "=&s"(_keep) : "v"(vo), "s"(gp), "s"(ld) : "memory"); } while (0)
#define PG8_STAGE(bufoff, gbase, voff) do { const char* _g = (const char*)(gbase); const unsigned _l = ldsbase + (unsigned)(bufoff) + ldsw; \
        PG8_GLDS((voff)[0], _g, _l); PG8_GLDS((voff)[0], _g + r64step, _l + 8192u); } while (0)
#define PG8_LDA(dst, b, h) do { _Pragma("unroll") for (int m = 0; m < 4; ++m) _Pragma("unroll") for (int k = 0; k < 2; ++k) dst[m][k] = *(const PG8_LAS v4i32*)(lds + PG8_SA(b, h) + aoff + m * 2048 + k * 1024); } while (0)
#define PG8_LDB(dst, b, h) do { _Pragma("unroll") for (int n = 0; n < 2; ++n) _Pragma("unroll") for (int k = 0; k < 2; ++k) dst[n][k] = *(const PG8_LAS v4i32*)(lds + PG8_SB(b, h) + boff + n * 2048 + k * 1024); } while (0)
#define PG8_CAT(x0, x1) __builtin_shufflevector(x0, x1, 0, 1, 2, 3, 4, 5, 6, 7)
#define PG8_MMA(ai, bj, At, Bt) do { __builtin_amdgcn_s_setprio(1); _Pragma("unroll") for (int m = 0; m < 4; ++m) _Pragma("unroll") for (int n = 0; n < 2; ++n) { \
        if constexpr (F8) { acc[ai][bj][m][n] = __builtin_amdgcn_mfma_scale_f32_16x16x128_f8f6f4(PG8_CAT(Bt[n][0], Bt[n][1]), PG8_CAT(At[m][0], At[m][1]), acc[ai][bj][m][n], 0, 0, 0, 0x7F7F7F7F, 0, 0x7F7F7F7F); } \
        else { _Pragma("unroll") for (int k = 0; k < 2; ++k) acc[ai][bj][m][n] = __builtin_amdgcn_mfma_f32_16x16x32_bf16(__builtin_bit_cast(bf16x8, Bt[n][k]), __builtin_bit_cast(bf16x8, At[m][k]), acc[ai][bj][m][n], 0, 0, 0); } } __builtin_amdgcn_s_setprio(0); } while (0)
#define PG8_WAIT_V(n) asm volatile("s_waitcnt vmcnt(" #n ")" ::: "memory")
#define PG8_WAIT_L(n) asm volatile("s_waitcnt lgkmcnt(" #n ")" ::: "memory")
#define PG8_BAR __builtin_amdgcn_s_barrier()
#define PG8_SCHED __builtin_amdgcn_sched_barrier(0)
    Unit cur, nxt; int ui = 0;
    if (!S.next(0, cur)) return;
    f32x4 acc[2][2][4][2];
#pragma unroll
    for (int a = 0; a < 2; ++a)
#pragma unroll
        for (int b = 0; b < 2; ++b)
#pragma unroll
            for (int m = 0; m < 4; ++m)
#pragma unroll
                for (int n = 0; n < 2; ++n) acc[a][b][m][n] = (f32x4){0.f, 0.f, 0.f, 0.f};
    v4i32 At[4][2], B0[2][2], B1[2][2];
    const char* cA = (const char*)g.A + (size_t)cur.pm * tstep; const char* cB = (const char*)g.Bt + (size_t)cur.pn * tstep;
    S.a_ready(cur);
    if constexpr (SP2) {
        PG8_STAGE(PG8_SB(0, 0), cB, voffB); PG8_STAGE(PG8_SB(0, 1), cB + hstep, voffB); PG8_STAGE(PG8_SA(0, 0), cA, voffA); PG8_STAGE(PG8_SA(0, 1), cA + hstep, voffA);
        if (wr == 1) PG8_BAR;
        PG8_WAIT_V(2); PG8_BAR;
        PG8_STAGE(PG8_SB(1, 0), cB + kstep, voffB); PG8_STAGE(PG8_SA(1, 0), cA + kstep, voffA); PG8_STAGE(PG8_SB(1, 1), cB + hstep + kstep, voffB);
        PG8_WAIT_V(6); PG8_BAR;
    } else {
        PG8_STAGE(PG8_SB(0, 0), cB, voffB); PG8_STAGE(PG8_SA(0, 0), cA, voffA); PG8_STAGE(PG8_SB(0, 1), cB + hstep, voffB); PG8_STAGE(PG8_SA(0, 1), cA + hstep, voffA);
        if (wr == 1) PG8_BAR;
        PG8_WAIT_V(4); PG8_BAR;
        PG8_STAGE(PG8_SB(1, 0), cB + kstep, voffB); PG8_STAGE(PG8_SA(1, 0), cA + kstep, voffA); PG8_STAGE(PG8_SB(1, 1), cB + hstep + kstep, voffB);
        PG8_WAIT_V(6); PG8_BAR;
    }
    for (;;) {
        const bool has_next = S.next(ui + 1, nxt);
        const char* nA = has_next ? (const char*)g.A + (size_t)nxt.pm * tstep : cA; const char* nB = has_next ? (const char*)g.Bt + (size_t)nxt.pn * tstep : cB;
#pragma unroll 1
        for (int t = 0; t < nt; t += 2) {
            const bool last = (t == nt - 2);
            const char* a1 = cA + (size_t)(t + 1) * kstep;
            const char* a2 = last ? nA : cA + (size_t)(t + 2) * kstep; const char* b2 = last ? nB : cB + (size_t)(t + 2) * kstep;
            const char* a3 = a2 + kstep; const char* b3 = b2 + kstep;
            if (last && has_next) S.a_ready(nxt);
            if constexpr (SP2) {
            PG8_LDB(B0, 0, 0); PG8_LDB(B1, 0, 1); PG8_SCHED; PG8_LDA(At, 0, 0); PG8_STAGE(PG8_SA(1, 1), a1 + hstep, voffA);
            PG8_WAIT_V(8); PG8_WAIT_L(0); PG8_BAR; PG8_MMA(0, 0, At, B0); PG8_MMA(0, 1, At, B1); PG8_BAR; PG8_SCHED;
            PG8_LDA(At, 0, 1); PG8_STAGE(PG8_SB(0, 0), b2, voffB); PG8_STAGE(PG8_SB(0, 1), b2 + hstep, voffB); PG8_STAGE(PG8_SA(0, 0), a2, voffA);
            PG8_WAIT_V(8); PG8_WAIT_L(0); PG8_BAR; PG8_MMA(1, 0, At, B0); PG8_MMA(1, 1, At, B1); PG8_BAR; PG8_SCHED;
            PG8_LDB(B0, 1, 0); PG8_LDB(B1, 1, 1); PG8_SCHED; PG8_LDA(At, 1, 0); PG8_STAGE(PG8_SA(0, 1), a2 + hstep, voffA);
            PG8_WAIT_V(8); PG8_WAIT_L(0); PG8_BAR; PG8_MMA(0, 0, At, B0); PG8_MMA(0, 1, At, B1); PG8_BAR; PG8_SCHED;
            PG8_LDA(At, 1, 1); PG8_STAGE(PG8_SB(1, 0), b3, voffB); PG8_STAGE(PG8_SB(1, 1), b3 + hstep, voffB); PG8_STAGE(PG8_SA(1, 0), a3, voffA);
            PG8_WAIT_V(8); PG8_WAIT_L(0); PG8_BAR; PG8_MMA(1, 0, At, B0); PG8_MMA(1, 1, At, B1); PG8_BAR; PG8_SCHED;
            } else {
            PG8_LDB(B0, 0, 0); PG8_SCHED; PG8_LDA(At, 0, 0); PG8_STAGE(PG8_SA(1, 1), a1 + hstep, voffA);
            PG8_WAIT_L(8); PG8_BAR; PG8_WAIT_L(0); PG8_MMA(0, 0, At, B0); PG8_BAR; PG8_SCHED;
            PG8_LDB(B1, 0, 1); PG8_STAGE(PG8_SB(0, 0), b2, voffB);
            PG8_BAR; PG8_WAIT_L(0); PG8_MMA(0, 1, At, B1); PG8_BAR;
            PG8_LDA(At, 0, 1); PG8_STAGE(PG8_SA(0, 0), a2, voffA);
            PG8_BAR; PG8_WAIT_L(0); PG8_MMA(1, 0, At, B0); PG8_BAR; PG8_SCHED;
            PG8_STAGE(PG8_SB(0, 1), b2 + hstep, voffB);
            PG8_WAIT_V(6); PG8_BAR; PG8_MMA(1, 1, At, B1); PG8_BAR;
            PG8_LDB(B0, 1, 0); PG8_SCHED; PG8_LDA(At, 1, 0); PG8_STAGE(PG8_SA(0, 1), a2 + hstep, voffA);
            PG8_WAIT_L(8); PG8_BAR; PG8_WAIT_L(0); PG8_MMA(0, 0, At, B0); PG8_BAR; PG8_SCHED;
            PG8_LDB(B1, 1, 1); PG8_STAGE(PG8_SB(1, 0), b3, voffB);
            PG8_BAR; PG8_WAIT_L(0); PG8_MMA(0, 1, At, B1); PG8_BAR;
            PG8_LDA(At, 1, 1); PG8_STAGE(PG8_SA(1, 0), a3, voffA);
            PG8_BAR; PG8_WAIT_L(0); PG8_MMA(1, 0, At, B0); PG8_BAR; PG8_SCHED;
            PG8_STAGE(PG8_SB(1, 1), b3 + hstep, voffB);
            PG8_WAIT_V(6); PG8_BAR; PG8_MMA(1, 1, At, B1); PG8_BAR;
            }
        }
        if constexpr (ALIGN_EPI) { if (wr == 0) PG8_BAR; }
        if constexpr (!Epi::AFTER_DRAIN) { E(acc, cur, wr, wc, fr, fq); S.done(cur); }
        if (!has_next) break;
#pragma unroll
        for (int a = 0; a < 2; ++a)
#pragma unroll
            for (int b = 0; b < 2; ++b)
#pragma unroll
                for (int m = 0; m < 4; ++m)
#pragma unroll
                    for (int n = 0; n < 2; ++n) acc[a][b][m][n] = (f32x4){0.f, 0.f, 0.f, 0.f};
        cur = nxt; cA = nA; cB = nB; ++ui;
        if constexpr (ALIGN_EPI) { if (wr == 1) PG8_BAR; }
    }
    PG8_WAIT_V(0);
    if constexpr (!ALIGN_EPI) { if (wr == 0) PG8_BAR; }
    PG8_BAR;
    if constexpr (Epi::AFTER_DRAIN) { E.fused(acc, cur, wr, wc, fr, fq, lds, wid, lane); S.done(cur); }
#undef PG8_SA
#undef PG8_SB
#undef PG8_STAGE
#undef PG8_GLDS
#undef PG8_LDA
#undef PG8_LDB
#undef PG8_MMA
#undef PG8_CAT
#undef PG8_WAIT_V
#undef PG8_WAIT_L
#undef PG8_BAR
#undef PG8_SCHED
}
}
namespace cg = cooperative_groups;
#define LAS __attribute__((address_space(3)))
typedef unsigned short bf16_t;
typedef short bf16x8 __attribute__((ext_vector_type(8)));
typedef short s16x4 __attribute__((ext_vector_type(4)));
typedef short v4i16_t __attribute__((ext_vector_type(4)));
typedef float f32x4 __attribute__((ext_vector_type(4)));
typedef float f32x16 __attribute__((ext_vector_type(16)));
typedef unsigned u32x4 __attribute__((ext_vector_type(4)));
typedef unsigned u32x2 __attribute__((ext_vector_type(2)));

constexpr int NWAVES = 8, NTHR = 512;
constexpr int D = 1024, SEQ = 2048, NBATCH = 32, FF = 2816, NPROJ = 3072;
constexpr int MP = 65536, MS = 128, MV = MP + MS, MPAD = 65792;
constexpr float EPS = 1e-6f;
constexpr int LDS_BYTES = 147456;
constexpr size_t O_Y = 0, O_KP = 67239936, O_VP = O_KP + 33554432, O_CP = O_VP + 33554432, O_NP = O_CP + 1048576, O_MPR = O_NP + 8192,
                 O_KS = O_MPR + 128, O_VS = O_KS + 65536, O_CS = O_VS + 65536, O_NS = O_CS + 262144, O_MS = O_NS + 2048, O_END = O_MS + 32;
constexpr size_t MiB = 1u << 20;
constexpr size_t WS_CTL = 0, WS_MOD = 1 * MiB, WS_ROPE = 3 * MiB, WS_GATES = 4 * MiB, WS_W1I = 8 * MiB, WS_W1O = 20 * MiB, WS_WIN = 26 * MiB, WS_WO = 32 * MiB,
                 WS_W2I = 34 * MiB, WS_W2O = 46 * MiB, WS_SK = 52 * MiB, WS_SV = 61 * MiB, WS_H = 72 * MiB, WS_F = 202 * MiB, WS_P = 332 * MiB, WS_W1I8 = 720 * MiB, WS_W2I8 = 726 * MiB, WS_W2O8 = 732 * MiB, WS_X16 = 736 * MiB, WS_END = 866 * MiB;
constexpr float H8_SCALE = 8.0f, W8_SCALE = 256.0f, A8_SCALE = 4.0f;

typedef float f32x2c __attribute__((ext_vector_type(2))); typedef __bf16 bf16x2c __attribute__((ext_vector_type(2)));
__device__ __forceinline__ unsigned pk2(float lo, float hi) { const f32x2c v = {lo, hi}; return __builtin_bit_cast(unsigned, __builtin_convertvector(v, bf16x2c)); }
__device__ __forceinline__ unsigned f2bf(float f) { return pk2(f, f) & 0xffffu; }
__device__ __forceinline__ float bflo(unsigned u) { return __uint_as_float(u << 16); }
__device__ __forceinline__ float bfhi(unsigned u) { return __uint_as_float(u & 0xffff0000u); }
template <int CTRL> __device__ __forceinline__ float dpp_mov(float v) { return __int_as_float(__builtin_amdgcn_update_dpp(0, __float_as_int(v), CTRL, 0xf, 0xf, false)); }
__device__ __forceinline__ float wave_sum(float v) {
    v += dpp_mov<0xB1>(v); v += dpp_mov<0x4E>(v); v += dpp_mov<0x141>(v); v += dpp_mov<0x140>(v);
    const int iv = __float_as_int(v);
    const float r0 = __int_as_float(__builtin_amdgcn_readlane(iv, 0)), r1 = __int_as_float(__builtin_amdgcn_readlane(iv, 16)), r2 = __int_as_float(__builtin_amdgcn_readlane(iv, 32)), r3 = __int_as_float(__builtin_amdgcn_readlane(iv, 48));
    return (r0 + r1) + (r2 + r3);
}
__device__ __forceinline__ int crow(int r, int hi) { return (r & 3) + 8 * (r >> 2) + 4 * hi; }

struct Args { const float* in[23]; float* out; unsigned char* ws; int ph_lo, ph_hi; };

__device__ __forceinline__ unsigned pk4_fp8(float a, float b, float c, float d) { unsigned p = 0u; p = __builtin_amdgcn_cvt_pk_fp8_f32(a, b, p, false); p = __builtin_amdgcn_cvt_pk_fp8_f32(c, d, p, true); return p; }
__device__ __forceinline__ void p0_transpose_item(const float* W, int K, int N, bf16_t* WT, int k0, int sc0, int dr0, LAS float* scr, int lane, unsigned char* WT8 = nullptr) {
    float wv[32];
#pragma unroll
    for (int i = 0; i < 32; ++i) wv[i] = W[(size_t)(k0 + 2 * i + (lane >> 5)) * N + sc0 + (lane & 31)];
#pragma unroll
    for (int i = 0; i < 32; ++i) scr[(2 * i + (lane >> 5)) * 33 + (lane & 31)] = wv[i];
    asm volatile("s_waitcnt lgkmcnt(0)" ::: "memory");
    const int c = lane & 7;
#pragma unroll
    for (int j = 0; j < 4; ++j) { const int n = (lane >> 3) + 8 * j; const LAS float* s = scr + (8 * c) * 33 + n;
        u32x4 o; o.x = pk2(s[0 * 33], s[1 * 33]); o.y = pk2(s[2 * 33], s[3 * 33]); o.z = pk2(s[4 * 33], s[5 * 33]); o.w = pk2(s[6 * 33], s[7 * 33]);
        *(u32x4*)(WT + (size_t)(dr0 + n) * K + k0 + 8 * c) = o; }
    if (WT8) {
        const int c4 = lane & 3;
#pragma unroll
        for (int j = 0; j < 2; ++j) { const int n = (lane >> 2) + 16 * j; const LAS float* s = scr + (16 * c4) * 33 + n;
            u32x4 o; o.x = pk4_fp8(s[0] * W8_SCALE, s[33] * W8_SCALE, s[66] * W8_SCALE, s[99] * W8_SCALE); o.y = pk4_fp8(s[132] * W8_SCALE, s[165] * W8_SCALE, s[198] * W8_SCALE, s[231] * W8_SCALE);
            o.z = pk4_fp8(s[264] * W8_SCALE, s[297] * W8_SCALE, s[330] * W8_SCALE, s[363] * W8_SCALE); o.w = pk4_fp8(s[396] * W8_SCALE, s[429] * W8_SCALE, s[462] * W8_SCALE, s[495] * W8_SCALE);
            *(u32x4*)(WT8 + (size_t)(dr0 + n) * K + k0 + 16 * c4) = o; }
    }
    asm volatile("s_waitcnt lgkmcnt(0)" ::: "memory");
}
__device__ __forceinline__ int ffn_in_src(int dr0) { const int tile = dr0 >> 8, w0 = dr0 & 255; return (w0 < 128) ? (128 * tile + w0) : (FF + 128 * tile + w0 - 128); }

__device__ __forceinline__ void p0_prologue(const Args& a, LAS unsigned char* lds) {
    int tid = threadIdx.x; asm volatile("" : "+v"(tid));
    const int lane = tid & 63, wave = __builtin_amdgcn_readfirstlane(tid >> 6);
    const int G = gridDim.x;
    unsigned char* ws = a.ws;
    if (blockIdx.x == 0 && wave == 0) {
        const float* lq = a.in[19];
        float a0 = lq[lane] * lq[64 + lane], a1 = lq[128 + lane] * lq[192 + lane];
        a0 = wave_sum(a0); a1 = wave_sum(a1);
        if (lane == 0) { ((float*)(ws + WS_CTL))[64] = __expf(a0) - __expf(a1) + 0.2f; }
    }
    {
        const float* cp = a.in[7]; const float* csm = a.in[8]; const float* wada = a.in[9]; const float* bada = a.in[10];
        float* mod = (float*)(ws + WS_MOD);
        LAS float* sct = (LAS float*)lds;
        LAS float* red = (LAS float*)(lds + 81920);
        for (int it = blockIdx.x; it < 576; it += G) {
            const int cgp = it >> 1, rh = it & 1;
            for (int i = tid; i < 20480; i += NTHR) { const int rr = i >> 10, k = i & 1023, grow = 20 * rh + rr;
                const float c = grow < 32 ? cp[grow * 1024 + k] : csm[(grow - 32) * 1024 + k];
                sct[k * 20 + rr] = c * __builtin_amdgcn_rcpf(1.0f + __expf(-c)); }
            __syncthreads();
            const int col = tid & 31, ks = tid >> 5;
            float acc[20];
#pragma unroll
            for (int r = 0; r < 20; ++r) acc[r] = 0.f;
            const float* wp = wada + (size_t)(64 * ks) * 9216 + 32 * cgp + col;
            float wv[64];
#pragma unroll
            for (int kk = 0; kk < 64; ++kk) wv[kk] = wp[(size_t)kk * 9216];
#pragma unroll
            for (int kk = 0; kk < 64; ++kk) {
                const float w = wv[kk];
                const LAS f32x4* s4 = (const LAS f32x4*)(sct + (64 * ks + kk) * 20);
#pragma unroll
                for (int q = 0; q < 5; ++q) { const f32x4 s = s4[q]; acc[4 * q] += s[0] * w; acc[4 * q + 1] += s[1] * w; acc[4 * q + 2] += s[2] * w; acc[4 * q + 3] += s[3] * w; }
            }
#pragma unroll
            for (int r = 0; r < 20; ++r) red[(ks * 20 + r) * 32 + col] = acc[r];
            __syncthreads();
            for (int i = tid; i < 640; i += NTHR) { const int r = i >> 5, c2 = i & 31; float s = bada[32 * cgp + c2];
#pragma unroll
                for (int k2 = 0; k2 < 16; ++k2) s += red[(k2 * 20 + r) * 32 + c2];
                mod[(size_t)(20 * rh + r) * 9216 + 32 * cgp + c2] = s; }
            __syncthreads();
        }
    }
    {
        LAS float* scr = (LAS float*)(lds + wave * 16384);
        const int gw = blockIdx.x * NWAVES + wave, NGW = G * NWAVES;
        constexpr int I_1I = 16 * 176, I_1O = 44 * 32, I_IN = 16 * 96, I_O = 16 * 32;
        constexpr int NITEMS = 2 * I_1I + 2 * I_1O + I_IN + I_O;
        for (int it = gw; it < NITEMS; it += NGW) {
            int r = it;
            if (r < I_1I) { const int kb = r / 176, nb = r % 176; p0_transpose_item(a.in[12], D, 2 * FF, (bf16_t*)(ws + WS_W1I), 64 * kb, ffn_in_src(32 * nb), 32 * nb, scr, lane); continue; } r -= I_1I;
            if (r < I_1I) { const int kb = r / 176, nb = r % 176; p0_transpose_item(a.in[21], D, 2 * FF, (bf16_t*)(ws + WS_W2I), 64 * kb, ffn_in_src(32 * nb), 32 * nb, scr, lane, ws + WS_W2I8); continue; } r -= I_1I;
            if (r < I_1O) { const int kb = r / 32, nb = r % 32; p0_transpose_item(a.in[13], FF, D, (bf16_t*)(ws + WS_W1O), 64 * kb, 32 * nb, 32 * nb, scr, lane); continue; } r -= I_1O;
            if (r < I_1O) { const int kb = r / 32, nb = r % 32; p0_transpose_item(a.in[22], FF, D, (bf16_t*)(ws + WS_W2O), 64 * kb, 32 * nb, 32 * nb, scr, lane, ws + WS_W2O8); continue; } r -= I_1O;
            if (r < I_IN) { const int kb = r / 96, nb = r % 96; p0_transpose_item(a.in[14], D, 3080, (bf16_t*)(ws + WS_WIN), 64 * kb, 32 * nb + (nb >= 48 ? 8 : 0), 32 * nb, scr, lane); continue; } r -= I_IN;
            { const int kb = r / 32, nb = r % 32; p0_transpose_item(a.in[20], D, D, (bf16_t*)(ws + WS_WO), 64 * kb, 32 * nb, 32 * nb, scr, lane); }
        }
    }
    {
        const int gt = blockIdx.x * NTHR + tid, NGT = G * NTHR;
        for (int i = gt; i < 2 * 524288; i += NGT) {
            const int ten = i >> 19, j = i & 524287, b = j >> 16, rem = j & 65535, pos = rem >> 6, ch = rem & 63;
            const float* src = a.in[2 + ten] + ((size_t)(b * 1024 + pos) * 512 + ch * 8);
            const f32x4 x0 = *(const f32x4*)src, x1 = *(const f32x4*)(src + 4);
            u32x4 o; o.x = pk2(x0[0], x0[1]); o.y = pk2(x0[2], x0[3]); o.z = pk2(x1[0], x1[1]); o.w = pk2(x1[2], x1[3]);
            *(u32x4*)((bf16_t*)(ws + (ten ? WS_SV : WS_SK)) + ((size_t)(b * 1088 + pos) * 512 + ch * 8)) = o;
        }
        float* rope = (float*)(ws + WS_ROPE);
        for (int i = gt; i < 2048 * 8; i += NGT) {
            const int pos = i >> 3, fi = i & 7;
            const double invf = fi == 0 ? 1.0 : fi == 1 ? 0.19392274474868576 : fi == 2 ? 0.03760603093086393 : fi == 3 ? 0.007292664737217109 : fi == 4 ? 0.001414213562373095
                              : fi == 5 ? 0.0002742481756762073 : fi == 6 ? 5.318295896944988e-05 : 1.031338537721246e-05;
            const double ang = (double)pos * invf;
            const double n = __builtin_rint(ang * 0.15915494309189535);
            const double rr = __builtin_fma(-n, 6.283185307179586, ang);
            const double kq = __builtin_rint(rr * 0.6366197723675814);
            const double y = __builtin_fma(-kq, 1.5707963267948966, rr), y2 = y * y;
            const double sn = y * (1.0 - y2 / 6.0 * (1.0 - y2 / 20.0 * (1.0 - y2 / 42.0 * (1.0 - y2 / 72.0 * (1.0 - y2 / 110.0 * (1.0 - y2 / 156.0))))));
            const double cs = 1.0 - y2 / 2.0 * (1.0 - y2 / 12.0 * (1.0 - y2 / 30.0 * (1.0 - y2 / 56.0 * (1.0 - y2 / 90.0 * (1.0 - y2 / 132.0)))));
            const int q = ((int)kq) & 3;
            const double c = q == 0 ? cs : q == 1 ? -sn : q == 2 ? -cs : sn;
            const double s = q == 0 ? sn : q == 1 ? cs : q == 2 ? -sn : -cs;
            rope[pos * 16 + fi] = (float)c; rope[pos * 16 + 8 + fi] = (float)s;
        }
    }
}

template <bool HAS_F, bool HAS_H, bool GATES, bool H8 = false  , bool XIN16 = false, bool XOUT16 = false  >
__device__ __forceinline__ void row_phase(const Args& a, LAS unsigned char* lds, const float* xin_p, const float* xin_s, float* xout, int kg, float rw, int gpost, int gpre, int ksh, int ksc) {
    int tid = threadIdx.x; asm volatile("" : "+v"(tid));
    const int lane = tid & 63, wave = __builtin_amdgcn_readfirstlane(tid >> 6);
    const int gw = blockIdx.x * NWAVES + wave, NGW = gridDim.x * NWAVES;
    unsigned char* ws = a.ws;
    const float* mod = (const float*)(ws + WS_MOD);
    const float* gn = a.in[11];
    const bf16_t* F = (const bf16_t*)(ws + WS_F);
    bf16_t* H = (bf16_t*)(ws + WS_H); bf16_t* X16 = (bf16_t*)(ws + WS_X16);
    float* gates = (float*)(ws + WS_GATES);
    LAS float* wg = (LAS float*)lds;
    if (GATES) {
        const float* win = a.in[14];
        for (int i = tid; i < 8192; i += NTHR) wg[i] = win[(size_t)(i >> 3) * 3080 + 1536 + (i & 7)];
        __syncthreads();
    }
    if (HAS_H && !HAS_F) {
        for (int i = blockIdx.x * NTHR + tid; i < (MPAD - MV) * D / 8; i += gridDim.x * NTHR) *(u32x4*)(H + (size_t)MV * D + (size_t)i * 8) = (u32x4){0u, 0u, 0u, 0u};
    }
    for (int ch = gw; ch < 2048 + MS; ch += NGW) {
        const bool samp = ch >= 2048;
        const int row0 = samp ? MP + (ch - 2048) : ch * 32, nrows = samp ? 1 : 32;
        const int mb = samp ? 32 + ((ch - 2048) >> 4) : (ch >> 6);
        const float* mrow = mod + (size_t)mb * 9216;
        f32x4 A1[4], A2[4], A3[4];
#pragma unroll
        for (int j = 0; j < 4; ++j) {
            const int e = 4 * lane + 256 * j;
            if (HAS_F && !GATES) { const f32x4 mg = *(const f32x4*)(mrow + kg * 1024 + e), gp = *(const f32x4*)(gn + gpost * 1024 + e); A1[j] = mg * gp * rw; }
            if (HAS_H) { const f32x4 gp = *(const f32x4*)(gn + gpre * 1024 + e), sc = *(const f32x4*)(mrow + ksc * 1024 + e); A2[j] = gp * (sc + 1.0f); if (!GATES) A3[j] = *(const f32x4*)(mrow + ksh * 1024 + e); }
        }
        for (int rr = 0; rr < nrows; ++rr) {
            const int row = row0 + rr;
            const float* xr = samp ? xin_s + (size_t)(row - MP) * D : xin_p + (size_t)row * D;
            f32x4 x[4];
#pragma unroll
            for (int j = 0; j < 4; ++j) {
                if (XIN16) { const u32x2 u = *(const u32x2*)(X16 + (size_t)row * D + 4 * lane + 256 * j); x[j] = (f32x4){bflo(u.x), bfhi(u.x), bflo(u.y), bfhi(u.y)}; }
                else x[j] = *(const f32x4*)(xr + 4 * lane + 256 * j);
            }
            if (HAS_F) {
                f32x4 f[4]; float ss = 0.f;
#pragma unroll
                for (int j = 0; j < 4; ++j) { const u32x2 u = *(const u32x2*)(F + (size_t)row * D + 4 * lane + 256 * j);
                    f[j] = (f32x4){bflo(u.x), bfhi(u.x), bflo(u.y), bfhi(u.y)}; ss += (f[j][0] * f[j][0] + f[j][1] * f[j][1]) + (f[j][2] * f[j][2] + f[j][3] * f[j][3]); }
                const float rstd = __builtin_amdgcn_rsqf(wave_sum(ss) * (1.0f / D) + EPS);
#pragma unroll
                for (int j = 0; j < 4; ++j) { f32x4 a1; if (GATES) { const int e = 4 * lane + 256 * j; a1 = *(const f32x4*)(mrow + kg * 1024 + e) * *(const f32x4*)(gn + gpost * 1024 + e) * rw; } else a1 = A1[j];
                    x[j] = x[j] + a1 * f[j] * rstd;
                    if (XOUT16) { u32x2 o; o.x = pk2(x[j][0], x[j][1]); o.y = pk2(x[j][2], x[j][3]); *(u32x2*)(X16 + (size_t)row * D + 4 * lane + 256 * j) = o; }
                    else *(f32x4*)(xout + (size_t)row * D + 4 * lane + 256 * j) = x[j]; }
            }
            if (HAS_H) {
                float ss = 0.f;
#pragma unroll
                for (int j = 0; j < 4; ++j) ss += (x[j][0] * x[j][0] + x[j][1] * x[j][1]) + (x[j][2] * x[j][2] + x[j][3] * x[j][3]);
                const float rstd = __builtin_amdgcn_rsqf(wave_sum(ss) * (1.0f / D) + EPS);
                f32x4 h[4];
#pragma unroll
                for (int j = 0; j < 4; ++j) { const f32x4 sh = GATES ? *(const f32x4*)(mrow + ksh * 1024 + 4 * lane + 256 * j) : A3[j]; h[j] = x[j] * rstd * A2[j] + sh;
                    if (H8 && !samp) { *(unsigned*)((unsigned char*)H + (size_t)row * D + 4 * lane + 256 * j) = pk4_fp8(h[j][0] * H8_SCALE, h[j][1] * H8_SCALE, h[j][2] * H8_SCALE, h[j][3] * H8_SCALE); }
                    else { u32x2 o; o.x = pk2(h[j][0], h[j][1]); o.y = pk2(h[j][2], h[j][3]); *(u32x2*)(H + (size_t)row * D + 4 * lane + 256 * j) = o; } }
                if (GATES) {
                    float g[8];
#pragma unroll
                    for (int q = 0; q < 8; ++q) g[q] = 0.f;
#pragma unroll
                    for (int j = 0; j < 4; ++j)
#pragma unroll
                        for (int e = 0; e < 4; ++e) { const LAS f32x4* wp = (const LAS f32x4*)(wg + (4 * lane + 256 * j + e) * 8); const f32x4 w0 = wp[0], w1 = wp[1]; const float hv = h[j][e];
                            g[0] += hv * w0[0]; g[1] += hv * w0[1]; g[2] += hv * w0[2]; g[3] += hv * w0[3]; g[4] += hv * w1[0]; g[5] += hv * w1[1]; g[6] += hv * w1[2]; g[7] += hv * w1[3]; }
#pragma unroll
                    for (int q = 0; q < 8; ++q) g[q] = wave_sum(g[q]);
                    const float gsel = lane == 0 ? g[0] : lane == 1 ? g[1] : lane == 2 ? g[2] : lane == 3 ? g[3] : lane == 4 ? g[4] : lane == 5 ? g[5] : lane == 6 ? g[6] : g[7];
                    if (lane < 8) {
                        float v;
                        if (lane < 4) v = gsel + a.in[15][lane];
                        else { const float z = gsel + a.in[16][lane - 4]; v = fminf(z, 0.f) - log1pf(__expf(-fabsf(z))); }
                        gates[(size_t)row * 8 + lane] = v;
                    }
                }
            }
        }
    }
}
typedef LAS unsigned char* ldsp;
__device__ __forceinline__ bf16x8 lds_frag(ldsp p) { return *(const LAS bf16x8*)p; }
__device__ __forceinline__ s16x4 vtr(ldsp p) { return __builtin_bit_cast(s16x4, __builtin_amdgcn_ds_read_tr16_b64_v4i16((LAS v4i16_t*)p)); }
__device__ __forceinline__ bf16x8 vtr2(ldsp p) { const s16x4 lo = vtr(p), hi = vtr(p + 512); return (bf16x8){lo[0], lo[1], lo[2], lo[3], hi[0], hi[1], hi[2], hi[3]}; }
__device__ __forceinline__ bf16x8 pack8(const f32x16& p, int s) {
    u32x4 w; w.x = pg8::cvt_pk_bf16(p[8 * s + 0], p[8 * s + 1]); w.y = pg8::cvt_pk_bf16(p[8 * s + 2], p[8 * s + 3]); w.z = pg8::cvt_pk_bf16(p[8 * s + 4], p[8 * s + 5]); w.w = pg8::cvt_pk_bf16(p[8 * s + 6], p[8 * s + 7]);
    return __builtin_bit_cast(bf16x8, w);
}
__device__ __forceinline__ int rimg(int row, int c, int nrows) { return c * nrows * 16 + ((row ^ (c & 7)) * 16); }
__device__ __forceinline__ int timg(int s, int c16) { return (c16 >> 2) * 4096 + (s >> 3) * 512 + (s & 7) * 64 + (c16 & 3) * 16; }

constexpr float LOG2E = 1.4426950408889634f;
__device__ __forceinline__ float max3f(float a, float b, float c) { float r; asm("v_max3_f32 %0, %1, %2, %3" : "=v"(r) : "v"(a), "v"(b), "v"(c)); return r; }
constexpr float AT_THR = 8.0f;
constexpr int AT_Q = 0, AT_KV = 32768, AT_KVB = 32768, AT_V = 16384, AT_X = 0;

__device__ __forceinline__ void attn_unit(ldsp lds, const bf16_t* Qg, int qstride, int nq_valid, const bf16_t* Kg, const bf16_t* Vg, int kvstride, int NT, int lim, int nvalid_last,
                                          bf16_t* Og, const float* gd, float lam) {
    int tid = threadIdx.x; asm volatile("" : "+v"(tid));
    const int lane = tid & 63, w = __builtin_amdgcn_readfirstlane(tid >> 6), r32 = lane & 31, hi = lane >> 5;
    const int rg = w >> 1, c = w & 1;
#pragma unroll
    for (int i = 0; i < 4; ++i) { const int id = tid + NTHR * i, row = id >> 4, c16 = id & 15, srow = row < nq_valid ? row : 0;
        const u32x4 v = *(const u32x4*)(Qg + (size_t)srow * qstride + c16 * 8);
        *(LAS u32x4*)(lds + AT_Q + rimg(row, c16, 128)) = v; }
    const int key0 = tid >> 4, cc = tid & 15;
    const bf16_t* kp = Kg + (size_t)key0 * kvstride + cc * 8; const bf16_t* vp = Vg + (size_t)key0 * kvstride + cc * 8;
    u32x4 kr0, kr1, vr0, vr1;
    kr0 = *(const u32x4*)kp; kr1 = *(const u32x4*)(kp + (size_t)32 * kvstride); vr0 = *(const u32x4*)vp; vr1 = *(const u32x4*)(vp + (size_t)32 * kvstride);
    f32x16 O[4];
#pragma unroll
    for (int d = 0; d < 4; ++d)
#pragma unroll
        for (int r = 0; r < 16; ++r) O[d][r] = 0.f;
    float lrun = 0.f;
    f32x16 negm;
#pragma unroll
    for (int r = 0; r < 16; ++r) negm[r] = 0.f;
    const int vlane = ((lane >> 4) & 1) * 32 + (lane & 3) * 8 + (4 * hi + ((lane & 15) >> 2)) * 64;
    for (int j = 0; j < NT; ++j) {
        const ldsp kb = lds + AT_KV + (j & 1) * AT_KVB; const ldsp vb = kb + AT_V;
        *(LAS u32x4*)(kb + rimg(key0, cc, 64)) = kr0; *(LAS u32x4*)(kb + rimg(key0 + 32, cc, 64)) = kr1;
        *(LAS u32x4*)(vb + timg(key0, cc)) = vr0; *(LAS u32x4*)(vb + timg(key0 + 32, cc)) = vr1;
        __syncthreads();
        if (j + 1 < NT) { const size_t o = (size_t)(64 * (j + 1)) * kvstride;
            kr0 = *(const u32x4*)(kp + o); kr1 = *(const u32x4*)(kp + o + (size_t)32 * kvstride); vr0 = *(const u32x4*)(vp + o); vr1 = *(const u32x4*)(vp + o + (size_t)32 * kvstride); }
        if (j <= lim) {
            const bool maskt = (j == NT - 1) && (nvalid_last < 64);
            f32x16 s0 = negm, s1 = negm;
#pragma unroll
            for (int st = 0; st < 4; ++st) {
                const int c16 = 8 * c + 2 * st + hi;
                const bf16x8 qf = lds_frag(lds + AT_Q + rimg(32 * rg + r32, c16, 128));
                const bf16x8 k0 = lds_frag(kb + rimg(r32, c16, 64)), k1 = lds_frag(kb + rimg(32 + r32, c16, 64));
                s0 = __builtin_amdgcn_mfma_f32_32x32x16_bf16(k0, qf, s0, 0, 0, 0);
                s1 = __builtin_amdgcn_mfma_f32_32x32x16_bf16(k1, qf, s1, 0, 0, 0);
            }
            if (maskt) {
#pragma unroll
                for (int r = 0; r < 16; ++r) { const int key = crow(r, hi); if (key >= nvalid_last) s0[r] = -INFINITY; if (key + 32 >= nvalid_last) s1[r] = -INFINITY; }
            }
            float mx = -INFINITY;
#pragma unroll
            for (int r = 0; r < 16; ++r) mx = max3f(mx, s0[r], s1[r]);
            if (j == 0 || __builtin_amdgcn_ballot_w64(mx > AT_THR) != 0ull) {
                mx = fmaxf(mx, __shfl_xor(mx, 32));
                const float delta = (j == 0) ? mx : fmaxf(mx, 0.f);
                const float alpha = (j == 0) ? 1.0f : __builtin_amdgcn_exp2f(-delta);
                lrun *= alpha;
#pragma unroll
                for (int r = 0; r < 16; ++r) { negm[r] -= delta; s0[r] -= delta; s1[r] -= delta; }
#pragma unroll
                for (int d = 0; d < 4; ++d)
#pragma unroll
                    for (int r = 0; r < 16; ++r) O[d][r] *= alpha;
            }
            float rs = 0.f;
#pragma unroll
            for (int r = 0; r < 16; ++r) { s0[r] = __builtin_amdgcn_exp2f(s0[r]); s1[r] = __builtin_amdgcn_exp2f(s1[r]); rs += s0[r] + s1[r]; }
            lrun += rs;
            const bf16x8 pf0 = pack8(s0, 0), pf1 = pack8(s0, 1), pf2 = pack8(s1, 0), pf3 = pack8(s1, 1);
#pragma unroll
            for (int d = 0; d < 4; ++d) {
                const ldsp vq = vb + vlane + d * 4096;
                O[d] = __builtin_amdgcn_mfma_f32_32x32x16_bf16(vtr2(vq), pf0, O[d], 0, 0, 0);
                O[d] = __builtin_amdgcn_mfma_f32_32x32x16_bf16(vtr2(vq + 1024), pf1, O[d], 0, 0, 0);
                O[d] = __builtin_amdgcn_mfma_f32_32x32x16_bf16(vtr2(vq + 2048), pf2, O[d], 0, 0, 0);
                O[d] = __builtin_amdgcn_mfma_f32_32x32x16_bf16(vtr2(vq + 3072), pf3, O[d], 0, 0, 0);
            }
        }
    }
    lrun += __shfl_xor(lrun, 32);
    __syncthreads();
    LAS float* xch = (LAS float*)(lds + AT_X) + rg * 4096 + lane;
    if (lim >= 0 && c == 1) {
        const float i1 = lam / lrun;
#pragma unroll
        for (int d = 0; d < 4; ++d)
#pragma unroll
            for (int r = 0; r < 16; ++r) xch[(d * 16 + r) * 64] = O[d][r] * i1;
    }
    __syncthreads();
    if (lim >= 0 && c == 0) {
        const float i0 = 1.0f / lrun;
        float ss = 0.f;
#pragma unroll
        for (int d = 0; d < 4; ++d)
#pragma unroll
            for (int r = 0; r < 16; ++r) { const float o = O[d][r] * i0 - xch[(d * 16 + r) * 64]; O[d][r] = o; ss += o * o; }
        ss += __shfl_xor(ss, 32);
        const float rstd = __builtin_amdgcn_rsqf(ss * (1.0f / 128.0f) + EPS) * 0.8f;
        const int q = 32 * rg + r32;
        if (q < nq_valid) {
            bf16_t* orow = Og + (size_t)q * D;
#pragma unroll
            for (int d = 0; d < 4; ++d)
#pragma unroll
                for (int g4 = 0; g4 < 4; ++g4) { const int dd = 32 * d + 8 * g4 + 4 * hi; const f32x4 gv = *(const f32x4*)(gd + dd);
                    u32x2 o; o.x = pk2(O[d][4 * g4] * rstd * gv[0], O[d][4 * g4 + 1] * rstd * gv[1]); o.y = pk2(O[d][4 * g4 + 2] * rstd * gv[2], O[d][4 * g4 + 3] * rstd * gv[3]);
                    *(u32x2*)(orow + dd) = o; }
        }
    }
}

constexpr int ML_BUFB = 40960, ML_Q = 0, ML_K = 8192, ML_KT = 16384, ML_V = 24576;
constexpr int ML_C = 81920, ML_A = 98304, ML_G = 106496, ML_B = 114688, ML_MP = 122880, ML_N = 123136, ML_SS = 123392;
__device__ __forceinline__ void mlstm_unit(ldsp lds, const bf16_t* Pb  , const float* gates  , int h, int nch, int ntok,
                                           const float* C0, const float* n0, const float* m0, bf16_t* Hb  , const float* gm  ,
                                           float* Cout, float* nout, float* mout) {
    int tid = threadIdx.x; asm volatile("" : "+v"(tid));
    const int lane = tid & 63, w = __builtin_amdgcn_readfirstlane(tid >> 6), r32 = lane & 31, hi = lane >> 5;
    const int T = nch * 64;
    LAS float* la = (LAS float*)(lds + ML_A); LAS float* lg = (LAS float*)(lds + ML_G); LAS float* lb = (LAS float*)(lds + ML_B);
    LAS float* lmp = (LAS float*)(lds + ML_MP); LAS float* ln = (LAS float*)(lds + ML_N); LAS float* lss = (LAS float*)(lds + ML_SS);
    for (int t = tid; t < T; t += NTHR) { const bool ok = (t & 63) < ntok; const int rowt = (t >> 6) * 64 + (t & 63);
        la[t] = ok ? gates[(size_t)rowt * 8 + h] : -1e30f; lb[t] = ok ? gates[(size_t)rowt * 8 + 4 + h] : 0.f; }
    if (tid < 64) *(LAS bf16_t*)(lds + ML_N + tid * 2) = (bf16_t)f2bf(n0 ? n0[tid] : 0.f);
    __syncthreads();
    if (w == 0) {
        float mcur = m0 ? m0[0] : 0.f;
        for (int c = 0; c < nch; ++c) {
            float b = lb[64 * c + lane];
#pragma unroll
            for (int o = 1; o < 64; o <<= 1) { const float t = __shfl_up(b, o); if (lane >= o) b += t; }
            const float av = la[64 * c + lane] - b;
            float cm = av;
#pragma unroll
            for (int o = 1; o < 64; o <<= 1) { const float t = __shfl_up(cm, o); if (lane >= o) cm = fmaxf(cm, t); }
            const float g = fmaxf(mcur, cm);
            la[64 * c + lane] = av; lg[64 * c + lane] = g; lb[64 * c + lane] = b;
            if (lane == 0) lmp[c] = mcur;
            mcur = __shfl(b + g, 63);
        }
        if (lane == 0) { lmp[nch] = mcur; mout[0] = mcur; }
    }
    const int vb = w >> 1, db = w & 1, tb = w & 1;
    f32x16 Cacc;
    float nreg = n0 ? n0[32 * db + r32] : 0.f;
#pragma unroll
    for (int r = 0; r < 16; ++r) { const int dv = 32 * vb + crow(r, hi), dk = 32 * db + r32; Cacc[r] = C0 ? C0[dv * 64 + dk] : 0.f; }
#pragma unroll
    for (int r = 0; r < 16; ++r) { const int dv = 32 * vb + crow(r, hi), dk = 32 * db + r32; *(LAS bf16_t*)(lds + ML_C + rimg(dv, dk >> 3, 128) + (dk & 7) * 2) = (bf16_t)f2bf(Cacc[r]); }
    const int st = tid >> 3, sc8 = tid & 7, sv0 = tid >> 4, sc16 = tid & 15;
    u32x4 qr, kr, v0r, v1r;
    {
        const bool ok = st < ntok; const bool ok0 = sv0 < ntok, ok1 = sv0 + 32 < ntok; const u32x4 z = {0u, 0u, 0u, 0u};
        qr = ok ? *(const u32x4*)(Pb + (size_t)st * NPROJ + h * 64 + sc8 * 8) : z; kr = ok ? *(const u32x4*)(Pb + (size_t)st * NPROJ + 256 + h * 64 + sc8 * 8) : z;
        v0r = ok0 ? *(const u32x4*)(Pb + (size_t)sv0 * NPROJ + 512 + h * 128 + sc16 * 8) : z; v1r = ok1 ? *(const u32x4*)(Pb + (size_t)(sv0 + 32) * NPROJ + 512 + h * 128 + sc16 * 8) : z;
    }
    __syncthreads();
    const int vlane = ((lane >> 4) & 1) * 32 + (lane & 3) * 8 + (4 * hi + ((lane & 15) >> 2)) * 64;
    for (int c = 0; c < nch; ++c) {
        const ldsp buf = lds + (c & 1) * ML_BUFB;
        {
            const float g63 = lg[64 * c + 63];
            const float wr = __expf(la[64 * c + st] - g63);
            *(LAS u32x4*)(buf + ML_Q + rimg(st, sc8, 64)) = qr; *(LAS u32x4*)(buf + ML_K + rimg(st, sc8, 64)) = kr;
            u32x4 ks; ks.x = pk2(bflo(kr.x) * wr, bfhi(kr.x) * wr); ks.y = pk2(bflo(kr.y) * wr, bfhi(kr.y) * wr); ks.z = pk2(bflo(kr.z) * wr, bfhi(kr.z) * wr); ks.w = pk2(bflo(kr.w) * wr, bfhi(kr.w) * wr);
            *(LAS u32x4*)(buf + ML_KT + timg(st, sc8)) = ks;
            *(LAS u32x4*)(buf + ML_V + timg(sv0, sc16)) = v0r; *(LAS u32x4*)(buf + ML_V + timg(sv0 + 32, sc16)) = v1r;
        }
        __syncthreads();
        const int t = 32 * tb + r32;
        if (c + 1 < nch) {
            const bf16_t* Pn = Pb + (size_t)(64 * (c + 1)) * NPROJ;
            qr = *(const u32x4*)(Pn + (size_t)st * NPROJ + h * 64 + sc8 * 8); kr = *(const u32x4*)(Pn + (size_t)st * NPROJ + 256 + h * 64 + sc8 * 8);
            v0r = *(const u32x4*)(Pn + (size_t)sv0 * NPROJ + 512 + h * 128 + sc16 * 8); v1r = *(const u32x4*)(Pn + (size_t)(sv0 + 32) * NPROJ + 512 + h * 128 + sc16 * 8);
        }
        u32x2 ogr[4];
#pragma unroll
        for (int g4 = 0; g4 < 4; ++g4) ogr[g4] = *(const u32x2*)(Pb + (size_t)(64 * c + ((t & 63) < ntok ? t : 0)) * NPROJ + 1024 + h * 128 + 32 * vb + 8 * g4 + 4 * hi);
        const float gt = lg[64 * c + t], bt = lb[64 * c + t], mprev = lmp[c];
        f32x16 s0, s1, inter, nqa;
#pragma unroll
        for (int r = 0; r < 16; ++r) { s0[r] = 0.f; s1[r] = 0.f; inter[r] = 0.f; nqa[r] = 0.f; }
#pragma unroll
        for (int stp = 0; stp < 4; ++stp) {
            const int c8 = 2 * stp + hi;
            const bf16x8 qf = lds_frag(buf + ML_Q + rimg(t, c8, 64));
            const bf16x8 k0 = lds_frag(buf + ML_K + rimg(r32, c8, 64)), k1 = lds_frag(buf + ML_K + rimg(32 + r32, c8, 64));
            const bf16x8 cf = lds_frag(lds + ML_C + rimg(32 * vb + r32, c8, 128));
            s0 = __builtin_amdgcn_mfma_f32_32x32x16_bf16(k0, qf, s0, 0, 0, 0);
            s1 = __builtin_amdgcn_mfma_f32_32x32x16_bf16(k1, qf, s1, 0, 0, 0);
            inter = __builtin_amdgcn_mfma_f32_32x32x16_bf16(cf, qf, inter, 0, 0, 0);
            nqa = __builtin_amdgcn_mfma_f32_32x32x16_bf16(lds_frag(lds + ML_N + c8 * 16), qf, nqa, 0, 0, 0);
        }
        float dsum = 0.f;
#pragma unroll
        for (int r = 0; r < 16; ++r) {
            const int sA = crow(r, hi), sB = 32 + sA;
            const float wA = (sA <= t) ? __expf(la[64 * c + sA] - gt) : 0.f, wB = (sB <= t) ? __expf(la[64 * c + sB] - gt) : 0.f;
            s0[r] *= wA; s1[r] *= wB; dsum += s0[r] + s1[r];
        }
        dsum += __shfl_xor(dsum, 32);
        f32x16 intra;
#pragma unroll
        for (int r = 0; r < 16; ++r) intra[r] = 0.f;
        {
            const bf16x8 pf0 = pack8(s0, 0), pf1 = pack8(s0, 1), pf2 = pack8(s1, 0), pf3 = pack8(s1, 1);
            const ldsp vq = buf + ML_V + vlane + vb * 4096;
            intra = __builtin_amdgcn_mfma_f32_32x32x16_bf16(vtr2(vq), pf0, intra, 0, 0, 0);
            intra = __builtin_amdgcn_mfma_f32_32x32x16_bf16(vtr2(vq + 1024), pf1, intra, 0, 0, 0);
            intra = __builtin_amdgcn_mfma_f32_32x32x16_bf16(vtr2(vq + 2048), pf2, intra, 0, 0, 0);
            intra = __builtin_amdgcn_mfma_f32_32x32x16_bf16(vtr2(vq + 3072), pf3, intra, 0, 0, 0);
        }
        const float nq = nqa[0];
        const float winter = __expf(mprev - gt);
        float den = dsum + winter * nq;
        den = fmaxf(fabsf(den), __expf(-(bt + gt)));
        const float rden = 1.0f / den;
        float ssq = 0.f;
#pragma unroll
        for (int r = 0; r < 16; ++r) { const float hv = (intra[r] + winter * inter[r]) * rden; intra[r] = hv; ssq += hv * hv; }
        ssq += __shfl_xor(ssq, 32);
        if (hi == 0) lss[vb * 64 + t] = ssq;
        __syncthreads();
        {
            const float tot = lss[t] + lss[64 + t] + lss[128 + t] + lss[192 + t];
            const float rstd = __builtin_amdgcn_rsqf(tot * (1.0f / 128.0f) + EPS);
            if ((t & 63) < ntok) {
                const size_t rowo = (size_t)(64 * c + t);
                bf16_t* orow = Hb + rowo * D;
#pragma unroll
                for (int g4 = 0; g4 < 4; ++g4) { const int dd = 32 * vb + 8 * g4 + 4 * hi; const f32x4 gv = *(const f32x4*)(gm + dd); const u32x2 ov = ogr[g4];
                    u32x2 o; o.x = pk2(intra[4 * g4] * rstd * gv[0] * bflo(ov.x), intra[4 * g4 + 1] * rstd * gv[1] * bfhi(ov.x));
                    o.y = pk2(intra[4 * g4 + 2] * rstd * gv[2] * bflo(ov.y), intra[4 * g4 + 3] * rstd * gv[3] * bfhi(ov.y));
                    *(u32x2*)(orow + dd) = o; }
            }
        }
        {
            const float wstate = __expf(mprev - lg[64 * c + 63]);
#pragma unroll
            for (int r = 0; r < 16; ++r) Cacc[r] *= wstate;
            const ldsp vq = buf + ML_V + vlane + vb * 4096; const ldsp kq = buf + ML_KT + vlane + db * 4096;
            f32x16 nsum;
#pragma unroll
            for (int r = 0; r < 16; ++r) nsum[r] = 0.f;
            const bf16x8 ones = {0x3f80, 0x3f80, 0x3f80, 0x3f80, 0x3f80, 0x3f80, 0x3f80, 0x3f80};
#pragma unroll
            for (int ks = 0; ks < 4; ++ks) { const bf16x8 kf = vtr2(kq + ks * 1024); Cacc = __builtin_amdgcn_mfma_f32_32x32x16_bf16(vtr2(vq + ks * 1024), kf, Cacc, 0, 0, 0);
                nsum = __builtin_amdgcn_mfma_f32_32x32x16_bf16(ones, kf, nsum, 0, 0, 0); }
            nreg = nreg * wstate + nsum[0];
#pragma unroll
            for (int r = 0; r < 16; ++r) { const int dv = 32 * vb + crow(r, hi), dk = 32 * db + r32; *(LAS bf16_t*)(lds + ML_C + rimg(dv, dk >> 3, 128) + (dk & 7) * 2) = (bf16_t)f2bf(Cacc[r]); }
            if (vb == 0 && hi == 0) *(LAS bf16_t*)(lds + ML_N + (32 * db + r32) * 2) = (bf16_t)f2bf(nreg);
        }
    }
    __syncthreads();
#pragma unroll
    for (int r = 0; r < 16; ++r) { const int dv = 32 * vb + crow(r, hi), dk = 32 * db + r32; Cout[dv * 64 + dk] = Cacc[r]; }
    if (vb == 0 && hi == 0) nout[32 * db + r32] = nreg;
}

constexpr int U_ML = 128, U_AS = 32, U_AP = 2048, U_MS = 32, NUNITS = U_ML + U_AS + U_AP + U_MS;
__device__ __forceinline__ void mixer_phase(const Args& a, ldsp lds, int rep) {
    unsigned char* ws = a.ws;
    unsigned* ctr = (unsigned*)(ws + WS_CTL) + rep;
    const float lam = ((const float*)(ws + WS_CTL))[64];
    const bf16_t* P = (const bf16_t*)(ws + WS_P); bf16_t* H = (bf16_t*)(ws + WS_H);
    const float* gates = (const float*)(ws + WS_GATES);
    LAS unsigned* su = (LAS unsigned*)(lds + 131072);
    float* out = a.out;
    const int w = __builtin_amdgcn_readfirstlane(threadIdx.x >> 6);
    for (;;) {
        __syncthreads();
        if (threadIdx.x == 0) su[0] = atomicAdd(ctr, 1u);
        __syncthreads();
        int u = __builtin_amdgcn_readfirstlane((int)su[0]);
        if (u >= NUNITS) break;
        const bool is_ml = (u < U_ML) || (u >= U_ML + U_AS + U_AP);
        if (is_ml) {
            const bool samp = u >= U_ML; if (samp) u -= U_ML + U_AS + U_AP;
            const int b = u >> 2, h = u & 3;
            const size_t row0 = samp ? (size_t)(MP + 16 * b) : (size_t)b * SEQ;
            mlstm_unit(lds, P + row0 * NPROJ, gates + row0 * 8, h, samp ? 1 : 32, samp ? 16 : 64,
                       samp ? a.in[4] + (size_t)u * 8192 : nullptr, samp ? a.in[5] + u * 64 : nullptr, samp ? a.in[6] + u : nullptr,
                       H + row0 * D + h * 128, a.in[17] + h * 128,
                       out + (samp ? O_CS : O_CP) + (size_t)u * 8192, out + (samp ? O_NS : O_NP) + u * 64, out + (samp ? O_MS : O_MPR) + u);
        } else {
            u -= U_ML;
            const bool samp = u < U_AS; if (!samp) u -= U_AS;
            const int qb = samp ? 0 : 15 - (u >> 7), bh = samp ? u : (u & 127), b = bh >> 2, h = bh & 3;
            const size_t qrow0 = samp ? (size_t)(MP + 16 * b) : (size_t)b * SEQ + 128 * qb;
            const bf16_t* Kg = samp ? (const bf16_t*)(ws + WS_SK) + (size_t)b * 1088 * 512 + h * 128 : P + (size_t)b * SEQ * NPROJ + 2048 + h * 128;
            const bf16_t* Vg = samp ? (const bf16_t*)(ws + WS_SV) + (size_t)b * 1088 * 512 + h * 128 : P + (size_t)b * SEQ * NPROJ + 2560 + h * 128;
            const int lim = samp ? ((w >> 1) == 0 ? 16 : -1) : 2 * qb + (w >> 2);
            attn_unit(lds, P + qrow0 * NPROJ + 1536 + h * 128, NPROJ, samp ? 16 : 128, Kg, Vg, samp ? 512 : NPROJ, samp ? 17 : 2 * qb + 2, lim, samp ? 16 : 64,
                      H + qrow0 * D + 512 + h * 128, a.in[18] + h * 128, lam);
        }
    }
}

template <int MODE, int SB  , int NB  >
__device__ __forceinline__ void mini_gemm(ldsp lds, const bf16_t* A, const bf16_t* Bt, int K, int ntn, bf16_t* O, const Args& a) {
    int tid = threadIdx.x; asm volatile("" : "+v"(tid));
    const int lane = tid & 63, w = __builtin_amdgcn_readfirstlane(tid >> 6), r32 = lane & 31, hi = lane >> 5;
    LAS float* red = (LAS float*)lds;
    unsigned char* ws = a.ws;
    for (int task = blockIdx.x; task < 4 * ntn; task += gridDim.x) {
        const int mt = task / ntn, nt = task % ntn;
        const int wrow0 = (MODE == 1) ? (256 * (nt >> 2) + 32 * (nt & 3)) : 32 * nt;
        const bf16_t* ap = A + (size_t)(32 * mt + r32) * K + (size_t)w * (SB * NB * 16) + 8 * hi;
        const bf16_t* bp = Bt + (size_t)(wrow0 + r32) * K + (size_t)w * (SB * NB * 16) + 8 * hi;
        f32x16 acc0, acc1;
#pragma unroll
        for (int r = 0; r < 16; ++r) { acc0[r] = 0.f; acc1[r] = 0.f; }
#pragma unroll 1
        for (int nb = 0; nb < NB; ++nb) {
            bf16x8 af[SB], b0[SB], b1[SB];
#pragma unroll
            for (int i = 0; i < SB; ++i) { af[i] = *(const bf16x8*)(ap + (nb * SB + i) * 16); b0[i] = *(const bf16x8*)(bp + (nb * SB + i) * 16);
                if (MODE == 1) b1[i] = *(const bf16x8*)(bp + (size_t)128 * K + (nb * SB + i) * 16); }
#pragma unroll
            for (int i = 0; i < SB; ++i) { acc0 = __builtin_amdgcn_mfma_f32_32x32x16_bf16(b0[i], af[i], acc0, 0, 0, 0);
                if (MODE == 1) acc1 = __builtin_amdgcn_mfma_f32_32x32x16_bf16(b1[i], af[i], acc1, 0, 0, 0); }
        }
#pragma unroll
        for (int r = 0; r < 16; ++r) { red[((w * 2 + 0) * 16 + r) * 64 + lane] = acc0[r]; if (MODE == 1) red[((w * 2 + 1) * 16 + r) * 64 + lane] = acc1[r]; }
        __syncthreads();
        {
            LAS float* fin = (LAS float*)(lds + 65536);
#pragma unroll
            for (int rr = 0; rr < 2; ++rr) { const int r = 2 * w + rr; float s0 = 0.f, s1 = 0.f;
#pragma unroll
                for (int k = 0; k < 8; ++k) { s0 += red[((k * 2 + 0) * 16 + r) * 64 + lane]; if (MODE == 1) s1 += red[((k * 2 + 1) * 16 + r) * 64 + lane]; }
                fin[r * 64 + lane] = s0; if (MODE == 1) fin[(16 + r) * 64 + lane] = s1; }
        }
        __syncthreads();
        if (w == 0) {
            const LAS float* fin = (const LAS float*)(lds + 65536);
#pragma unroll
            for (int r = 0; r < 16; ++r) { acc0[r] = fin[r * 64 + lane]; acc1[r] = (MODE == 1) ? fin[(16 + r) * 64 + lane] : 0.f; }
            const int srow = 32 * mt + r32;
            if (MODE == 0) {
                bf16_t* o = O + (size_t)srow * D + 32 * nt;
#pragma unroll
                for (int g = 0; g < 4; ++g) { u32x2 v; v.x = pk2(acc0[4 * g], acc0[4 * g + 1]); v.y = pk2(acc0[4 * g + 2], acc0[4 * g + 3]); *(u32x2*)(o + 8 * g + 4 * hi) = v; }
            } else if (MODE == 1) {
                bf16_t* o = O + (size_t)srow * FF + 32 * nt;
#pragma unroll
                for (int r = 0; r < 16; ++r) acc0[r] = acc0[r] * pg8::fast_sigmoid(acc0[r]) * acc1[r];
#pragma unroll
                for (int g = 0; g < 4; ++g) { u32x2 v; v.x = pk2(acc0[4 * g], acc0[4 * g + 1]); v.y = pk2(acc0[4 * g + 2], acc0[4 * g + 3]); *(u32x2*)(o + 8 * g + 4 * hi) = v; }
            } else {
                const int col0 = 32 * nt, pn = col0 >> 8;
                const int type = (pn == 0) ? 0 : (pn == 1) ? 1 : (pn < 4) ? 2 : (pn < 6) ? 3 : (pn < 8) ? 4 : (pn < 10) ? 5 : 6;
                if (type == 1) {
#pragma unroll
                    for (int r = 0; r < 16; ++r) acc0[r] *= 0.125f;
                } else if (type == 3) {
#pragma unroll
                    for (int r = 0; r < 16; ++r) acc0[r] = pg8::fast_sigmoid(acc0[r]);
                } else if ((type == 4 || type == 5) && (col0 & 63) == 0) {
                    const float* t = (const float*)(ws + WS_ROPE) + (1024 + (srow & 15)) * 16 + 4 * hi;
                    const f32x4 cs = *(const f32x4*)t, sn = *(const f32x4*)(t + 8);
#pragma unroll
                    for (int j = 0; j < 4; ++j) { const float x1 = acc0[j], x2 = acc0[4 + j]; acc0[j] = x1 * cs[j] - x2 * sn[j]; acc0[4 + j] = x2 * cs[j] + x1 * sn[j]; }
                }
                if (type >= 5) {
                    const int c512 = col0 - (type == 5 ? 2048 : 2560);
                    float* o = a.out + (type == 5 ? O_KS : O_VS) + (size_t)srow * 512 + c512;
#pragma unroll
                    for (int g = 0; g < 4; ++g) *(f32x4*)(o + 8 * g + 4 * hi) = (f32x4){acc0[4 * g], acc0[4 * g + 1], acc0[4 * g + 2], acc0[4 * g + 3]};
                }
                if (type == 4) {
#pragma unroll
                    for (int r = 0; r < 16; ++r) acc0[r] *= (0.125f * 1.4426950408889634f);
                }
                bf16_t* o = O + (size_t)srow * NPROJ + col0;
                bf16_t* o2 = (bf16_t*)(ws + (type == 5 ? WS_SK : WS_SV)) + ((size_t)((srow >> 4) * 1088 + 1024 + (srow & 15)) * 512 + (col0 - (type == 5 ? 2048 : 2560)));
#pragma unroll
                for (int g = 0; g < 4; ++g) { u32x2 v; v.x = pk2(acc0[4 * g], acc0[4 * g + 1]); v.y = pk2(acc0[4 * g + 2], acc0[4 * g + 3]); *(u32x2*)(o + 8 * g + 4 * hi) = v;
                    if (type >= 5) *(u32x2*)(o2 + 8 * g + 4 * hi) = v; }
            }
        }
        __syncthreads();
    }
}

#define XB_TMO      128
#define XB_XCNT(j)  (256  + 64 * (j))
#define XB_XSUB(j)  (1280 + 64 * (j))
#define XB_XGEN(j)  (2304 + 64 * (j))
#define XB_TOP      3328
#define XB_TOPGEN   3392
#define XCD_BAR_WORDS 3456
#define XB_SPIN_CAP (1u << 22)

__device__ __forceinline__ unsigned xb_ld(unsigned* p)              { return __hip_atomic_load(p, __ATOMIC_RELAXED, __HIP_MEMORY_SCOPE_AGENT); }
__device__ __forceinline__ unsigned xb_add(unsigned* p, unsigned v) { return __hip_atomic_fetch_add(p, v, __ATOMIC_RELAXED, __HIP_MEMORY_SCOPE_AGENT); }
__device__ __forceinline__ unsigned xb_xcc_id() { return (unsigned)__builtin_amdgcn_s_getreg((3 << 11) | 20) & 0xFu; }
#define XB_SPIN(cond, bar) do { unsigned _sp = 0; while (cond) { __builtin_amdgcn_s_sleep(1); \
    if ((++_sp & 255u) == 0u) { if (xb_ld(&(bar)[XB_TMO])) break; if (_sp > XB_SPIN_CAP) { atomicAdd(&(bar)[XB_TMO], 1u); break; } } } } while (0)

struct XcdBarrier {
    unsigned* bar; unsigned x;
    volatile LAS unsigned* st;
};

__device__ __forceinline__ XcdBarrier xcd_barrier_post(unsigned* bar, volatile LAS unsigned* st) {
    XcdBarrier b; b.bar = bar; b.x = xb_xcc_id(); b.st = st;
    if (threadIdx.x == 0) (void)xb_add(&bar[XB_XCNT(b.x)], 1u);
    return b;
}
__device__ __forceinline__ void xcd_barrier_complete(unsigned* bar, unsigned x, unsigned& nloc, unsigned& nx) {
    const unsigned G = gridDim.x * gridDim.y * gridDim.z;
    unsigned sum, cnt, mine, sp = 0u;
    for (;;) {
        sum = 0u; cnt = 0u; mine = 0u;
#pragma unroll
        for (unsigned j = 0; j < 16; ++j) { const unsigned c = xb_ld(&bar[XB_XCNT(j)]); sum += c; cnt += (c > 0u) ? 1u : 0u; mine = (j == x) ? c : mine; }
        if (sum == G) break;
        __builtin_amdgcn_s_sleep(1);
        if ((++sp & 255u) == 0u) { if (xb_ld(&bar[XB_TMO])) break; if (sp > XB_SPIN_CAP) { atomicAdd(&bar[XB_TMO], 1u); break; } }
    }
    nloc = mine > 0u ? mine : 1u; nx = cnt > 0u ? cnt : 1u;
}

__device__ __forceinline__ void xcd_barrier(const XcdBarrier& b) {
    asm volatile("s_waitcnt vmcnt(0)" ::: "memory");
    __syncthreads();
    if (threadIdx.x == 0) {
        unsigned* bar = b.bar;
        __builtin_amdgcn_s_waitcnt(0);
        unsigned nloc = b.st[0], nx = b.st[1];
        if (nloc == 0u) { xcd_barrier_complete(bar, b.x, nloc, nx); b.st[0] = nloc; b.st[1] = nx; }
        const unsigned old = xb_add(&bar[XB_XSUB(b.x)], 1u);
        const unsigned gen = old / nloc;
        if (old + 1u == (gen + 1u) * nloc) {
            __builtin_amdgcn_fence(__ATOMIC_RELEASE, "agent");
            asm volatile("s_waitcnt vmcnt(0)" ::: "memory");
            const unsigned og = xb_add(&bar[XB_TOP], 1u);
            const unsigned tg = og / nx;
            if (og + 1u == (tg + 1u) * nx) xb_add(&bar[XB_TOPGEN], 1u);
            else XB_SPIN(xb_ld(&bar[XB_TOPGEN]) == tg, bar);
            __builtin_amdgcn_fence(__ATOMIC_ACQUIRE, "agent");
            xb_add(&bar[XB_XGEN(b.x)], 1u);
            asm volatile("s_waitcnt vmcnt(0)" ::: "memory");
        } else {
            XB_SPIN(xb_ld(&bar[XB_XGEN(b.x)]) == gen, bar);
            __builtin_amdgcn_fence(__ATOMIC_ACQUIRE, "agent");
            asm volatile("s_waitcnt vmcnt(0)" ::: "memory");
        }
    }
    __syncthreads();
}

constexpr int NPHASE = 12;
#ifndef REP_MASK
#define REP_MASK 0
#endif
template <bool COOP>
__global__ void __launch_bounds__(NTHR, 2) mega(Args a) {
    extern __shared__ __attribute__((aligned(16))) unsigned char lds_raw[];
    ldsp lds = (ldsp)lds_raw;
    unsigned char* ws = a.ws;
    const int lo = a.ph_lo, hi = a.ph_hi, G = gridDim.x, bx = blockIdx.x;
#define IN(k) (lo <= (k) && (k) < hi)
    XcdBarrier bar; bar.bar = (unsigned*)(ws + WS_CTL) + 4096; bar.x = 0; bar.st = nullptr;
    if (COOP) {
        volatile LAS unsigned* misc = (volatile LAS unsigned*)(lds + 131072 + 64);
        if (threadIdx.x < 2) misc[threadIdx.x] = 0u;
        __syncthreads();
        bar = xcd_barrier_post((unsigned*)(ws + WS_CTL) + 4096, misc);
    }
#define SEAM(k) do { if (COOP) { if (IN(k) && IN((k) + 1)) { if ((k) == 0) cg::this_grid().sync(); else xcd_barrier(bar); } } } while (0)
    bf16_t* H = (bf16_t*)(ws + WS_H); bf16_t* F = (bf16_t*)(ws + WS_F); bf16_t* P = (bf16_t*)(ws + WS_P);
    float* X = a.out + O_Y;
    if (IN(0)) { for (int rep = 0; rep < 1 + ((REP_MASK >> 0) & 1); ++rep) { if (rep) { if (COOP) xcd_barrier(bar); } p0_prologue(a, lds); } } SEAM(0);
    if (IN(1)) { for (int rep = 0; rep < 1 + ((REP_MASK >> 1) & 1); ++rep) { if (rep) { if (COOP) xcd_barrier(bar); } row_phase<false, true, false>(a, lds, a.in[0], a.in[1], nullptr, 0, 0.f, 0, 0, 0, 1); } } SEAM(1);
    if (IN(2)) { for (int rep = 0; rep < 1 + ((REP_MASK >> 2) & 1); ++rep) { if (rep) { if (COOP) xcd_barrier(bar); } pg8::Gemm g{H, (const bf16_t*)(ws + WS_W1I), MP, 2 * FF, D}; pg8::StaticOrder S; S.init(MP, 2 * FF, G, bx); pg8::EpiSwiglu E{P, FF, 1.0f};
        pg8::gemm_phase<pg8::EpiSwiglu, pg8::StaticOrder, true, true>(lds, g, S, E);
        mini_gemm<1, 8, 1>(lds, H + (size_t)MP * D, (const bf16_t*)(ws + WS_W1I), D, FF / 32, P + (size_t)MP * FF, a); } } SEAM(2);
    if (IN(3)) { for (int rep = 0; rep < 1 + ((REP_MASK >> 3) & 1); ++rep) { if (rep) { if (COOP) xcd_barrier(bar); } pg8::Gemm g{P, (const bf16_t*)(ws + WS_W1O), MP, D, FF}; pg8::StaticOrder S; S.init(MP, D, G, bx); pg8::EpiPlain E{F, D, 1.0f};
        pg8::gemm_phase<pg8::EpiPlain, pg8::StaticOrder, true, true>(lds, g, S, E);
        mini_gemm<0, 11, 2>(lds, P + (size_t)MP * FF, (const bf16_t*)(ws + WS_W1O), FF, D / 32, F + (size_t)MP * D, a); } } SEAM(3);
    if (IN(4)) { for (int rep = 0; rep < 1 + ((REP_MASK >> 4) & 1); ++rep) { if (rep) { if (COOP) xcd_barrier(bar); } row_phase<true, true, true, false, false, true>(a, lds, a.in[0], a.in[1], X, 2, 0.5f, 1, 2, 3, 4); } } SEAM(4);
    if (IN(5)) { for (int rep = 0; rep < 1 + ((REP_MASK >> 5) & 1); ++rep) { if (rep) { if (COOP) xcd_barrier(bar); } pg8::Gemm g{H, (const bf16_t*)(ws + WS_WIN), MP, NPROJ, D}; pg8::StaticOrder S; S.init(MP, NPROJ, G, bx);
        pg8::EpiProj E{P, (bf16_t*)(ws + WS_SK), (bf16_t*)(ws + WS_SV), a.out + O_KP, a.out + O_VP, a.out + O_KS, a.out + O_VS, (const float*)(ws + WS_ROPE)};
        pg8::gemm_phase<pg8::EpiProj, pg8::StaticOrder, true, true>(lds, g, S, E);
        mini_gemm<2, 8, 1>(lds, H + (size_t)MP * D, (const bf16_t*)(ws + WS_WIN), D, NPROJ / 32, P + (size_t)MP * NPROJ, a); } } SEAM(5);
    if (IN(6)) { for (int rep = 0; rep < 1 + ((REP_MASK >> 6) & 1); ++rep) { if (rep) { if (COOP) xcd_barrier(bar); } mixer_phase(a, lds, rep); } } SEAM(6);
    if (IN(7)) { for (int rep = 0; rep < 1 + ((REP_MASK >> 7) & 1); ++rep) { if (rep) { if (COOP) xcd_barrier(bar); } pg8::Gemm g{H, (const bf16_t*)(ws + WS_WO), MP, D, D}; pg8::StaticOrder S; S.init(MP, D, G, bx); pg8::EpiPlain E{F, D, 1.0f};
        pg8::gemm_phase<pg8::EpiPlain, pg8::StaticOrder, true, true>(lds, g, S, E);
        mini_gemm<0, 8, 1>(lds, H + (size_t)MP * D, (const bf16_t*)(ws + WS_WO), D, D / 32, F + (size_t)MP * D, a); } } SEAM(7);
    if (IN(8)) { for (int rep = 0; rep < 1 + ((REP_MASK >> 8) & 1); ++rep) { if (rep) { if (COOP) xcd_barrier(bar); } row_phase<true, true, false, true, true, true>(a, lds, X, X + (size_t)MP * D, X, 5, 1.0f, 3, 4, 6, 7); } } SEAM(8);
    if (IN(9)) { for (int rep = 0; rep < 1 + ((REP_MASK >> 9) & 1); ++rep) { if (rep) { if (COOP) xcd_barrier(bar); } pg8::Gemm g{H, (const bf16_t*)(ws + WS_W2I8), MP, 2 * FF, D / 2}; pg8::StaticOrder S; S.init(MP, 2 * FF, G, bx); pg8::EpiSwigluF8 E{(unsigned char*)P, FF, 1.0f / (H8_SCALE * W8_SCALE), A8_SCALE};
        pg8::gemm_phase<pg8::EpiSwigluF8, pg8::StaticOrder, true, true, true>(lds, g, S, E);
        mini_gemm<1, 8, 1>(lds, H + (size_t)MP * D, (const bf16_t*)(ws + WS_W2I), D, FF / 32, P + (size_t)MP * FF, a); } } SEAM(9);
    if (IN(10)) { for (int rep = 0; rep < 1 + ((REP_MASK >> 10) & 1); ++rep) { if (rep) { if (COOP) xcd_barrier(bar); } pg8::Gemm g{P, (const bf16_t*)(ws + WS_W2O8), MP, D, FF / 2}; pg8::StaticOrder S; S.init(MP, D, G, bx); pg8::EpiPlain E{F, D, 1.0f / (A8_SCALE * W8_SCALE)};
        pg8::gemm_phase<pg8::EpiPlain, pg8::StaticOrder, true, true, true>(lds, g, S, E);
        mini_gemm<0, 11, 2>(lds, P + (size_t)MP * FF, (const bf16_t*)(ws + WS_W2O), FF, D / 32, F + (size_t)MP * D, a); } } SEAM(10);
    if (IN(11)) { for (int rep = 0; rep < 1 + ((REP_MASK >> 11) & 1); ++rep) { if (rep) { if (COOP) xcd_barrier(bar); } row_phase<true, false, false, false, true, false>(a, lds, X, X + (size_t)MP * D, X, 8, 0.5f, 5, 0, 0, 0); } }
#undef IN
#undef SEAM
}

#ifndef MK_LAUNCHES
#define MK_LAUNCHES 1
#endif
extern "C" void kernel_launch(void* const* d_in, const int* in_sizes, int n_in, void* d_out, int out_size, void* d_ws, size_t ws_size, hipStream_t stream) {
    static int grid = 0;
    if (grid == 0) {
        if (n_in != 23 || (size_t)out_size != O_END || ws_size < WS_END) { fprintf(stderr, "kernel_launch: unexpected shapes (n_in %d, out %d, ws %zu)\n", n_in, out_size, ws_size); grid = -1; return; }
        int dev = 0, cus = 0, per_cu = 0;
        hipGetDevice(&dev); hipDeviceGetAttribute(&cus, hipDeviceAttributeMultiprocessorCount, dev);
        hipFuncSetAttribute((const void*)mega<true>, hipFuncAttributeMaxDynamicSharedMemorySize, LDS_BYTES);
        hipFuncSetAttribute((const void*)mega<false>, hipFuncAttributeMaxDynamicSharedMemorySize, LDS_BYTES);
        hipOccupancyMaxActiveBlocksPerMultiprocessor(&per_cu, (const void*)mega<true>, NTHR, LDS_BYTES);
        if (per_cu < 1) per_cu = 1;
        (void)hipGetLastError();
        grid = cus * per_cu;
    }
    if (grid < 0) return;
    if (hipMemsetAsync(d_ws, 0, 65536, stream) != hipSuccess) { fprintf(stderr, "kernel_launch: memset failed\n"); return; }
    Args a{};
    for (int i = 0; i < 23; ++i) a.in[i] = (const float*)d_in[i];
    a.out = (float*)d_out; a.ws = (unsigned char*)d_ws;
    if (MK_LAUNCHES == 1) {
        a.ph_lo = 0; a.ph_hi = NPHASE;
        void* args[] = {&a};
        hipError_t e = hipLaunchCooperativeKernel((const void*)mega<true>, dim3(grid), dim3(NTHR), args, LDS_BYTES, stream);
        if (e != hipSuccess) fprintf(stderr, "cooperative launch failed: %s (grid %d)\n", hipGetErrorString(e), grid);
    } else {
        for (int p = 0; p < NPHASE; ++p) { a.ph_lo = p; a.ph_hi = p + 1; hipLaunchKernelGGL(mega<false>, dim3(grid), dim3(NTHR), LDS_BYTES, stream, a); }
    }
}
```
